# Optimizing an MI355X kernel written in HIP

```python
import math
import jax, jax.numpy as jnp
from jax import lax
import numpy as np

D_MODEL = 1024
BATCH = 16
SEQ = 2048
DEPTH = 1
DEC_BATCH = 32
DEC_SEQ = 2048
PAST_LEN = 128

HEAD_DIM = 64
DIL_PATTERNS = ((128, 1), (512, 4), (2048, 16))
N_GROUPS_A = 3
HEADS_PER_GROUP_A = 6
N_HEADS_A = N_GROUPS_A * HEADS_PER_GROUP_A
WIDTH_A = N_HEADS_A * HEAD_DIM
DA_QBLOCK = 64
N_HEADS_B = 14
WIDTH_B = N_HEADS_B * HEAD_DIM
GRID_W = 64
NA_KH = 8
NA_KW = 16
NA_QCB = 16
IN_COLS = 4 * WIDTH_A + 4 * WIDTH_B + 2 * D_MODEL
SPLIT_POINTS = (WIDTH_A, 2 * WIDTH_A, 3 * WIDTH_A, 4 * WIDTH_A,
                4 * WIDTH_A + WIDTH_B, 4 * WIDTH_A + 2 * WIDTH_B, 4 * WIDTH_A + 3 * WIDTH_B, 4 * WIDTH_A + 4 * WIDTH_B,
                4 * WIDTH_A + 4 * WIDTH_B + D_MODEL)
RMS_EPS = 1e-6
NEG_INF = -1e30

kernel_name = "hybrid_dilated_neighbourhood_encoder"


def rms_norm(x, g):
    xf = x.astype(jnp.float32)
    y = xf * lax.rsqrt(jnp.mean(xf * xf, axis=-1, keepdims=True) + RMS_EPS)
    return (y * g.astype(jnp.float32)).astype(x.dtype)


def alibi_slopes():
    return jnp.asarray((2.0 ** (-8.0 * np.arange(1, N_HEADS_A + 1) / N_HEADS_A)).astype(np.float32))


def dilated_window_attention(q, k, v, window, dilation, slopes):
    b, t, h, e = q.shape
    d = dilation
    L = t // d
    half = (window // 2) // d
    qblk = math.gcd(L, DA_QBLOCK)
    nb = L // qblk
    kl = qblk + 2 * half
    qs = q.reshape(b, nb, qblk, d, h, e)
    pad = ((0, 0), (half, half), (0, 0), (0, 0), (0, 0))
    kp = jnp.pad(k.reshape(b, L, d, h, e), pad)
    vp = jnp.pad(v.reshape(b, L, d, h, e), pad)
    kidx = np.arange(nb)[:, None] * qblk + np.arange(kl)[None, :]
    kb = kp[:, kidx]
    vb = vp[:, kidx]
    s = jnp.einsum('bnqrhe,bnkrhe->bnrhqk', qs, kb, preferred_element_type=jnp.float32) * (e ** -0.5)
    off = np.arange(kl)[None, :] - half - np.arange(qblk)[:, None]
    kpos = kidx - half
    valid = (np.abs(off) <= half)[None] & ((kpos >= 0) & (kpos < L))[:, None, :]
    dist = (np.abs(off) * d).astype(np.float32)
    s = s - slopes[:, None, None] * dist
    s = jnp.where(valid[None, :, None, None], s, NEG_INF)
    lse = jax.nn.logsumexp(s, axis=-1)
    p = jnp.exp(s - lse[..., None])
    o = jnp.einsum('bnrhqk,bnkrhe->bnqrhe', p.astype(v.dtype), vb).reshape(b, t, h, e)
    lse = lse.transpose(0, 1, 4, 2, 3).reshape(b, t, h)
    return o, lse


def neighbourhood_attention(q, k, v, rpb):
    b, t, h, e = q.shape
    rows = t // GRID_W
    kh = min(NA_KH, rows)
    kw = NA_KW
    slab = NA_QCB + kw
    ncb = GRID_W // NA_QCB
    r = np.arange(rows)
    rs = np.clip(r - kh // 2, 0, rows - kh)
    key_rows = rs[:, None] + np.arange(kh)[None, :]
    c0 = np.arange(ncb) * NA_QCB
    s0 = np.clip(c0 - kw // 2, 0, GRID_W - slab)
    key_cols = s0[:, None] + np.arange(slab)[None, :]
    nk = kh * slab
    idx = (key_rows[:, None, :, None] * GRID_W + key_cols[None, :, None, :]).reshape(rows, ncb, nk)
    qcol = c0[:, None] + np.arange(NA_QCB)[None, :]
    cs = np.clip(qcol - kw // 2, 0, GRID_W - kw)
    col_valid = (key_cols[:, None, :] >= cs[:, :, None]) & (key_cols[:, None, :] < cs[:, :, None] + kw)
    valid = np.broadcast_to(col_valid[:, :, None, :], (ncb, NA_QCB, kh, slab)).reshape(ncb, NA_QCB, nk)
    dr = key_rows - r[:, None] + NA_KH - 1
    dc = np.clip(key_cols[:, None, :] - qcol[:, :, None], -(kw - 1), kw - 1) + kw - 1
    bias = rpb[:, dr[:, None, None, :, None], dc[None, :, :, None, :]]
    bias = bias.astype(jnp.float32).reshape(h, rows, ncb, NA_QCB, nk).transpose(1, 2, 0, 3, 4)
    qb = q.reshape(b, rows, ncb, NA_QCB, h, e)
    kb = k[:, idx]
    vb = v[:, idx]
    s = jnp.einsum('brcqhe,brckhe->brchqk', qb, kb, preferred_element_type=jnp.float32) * (e ** -0.5)
    s = s + bias[None]
    s = jnp.where(valid[None, None, :, None, :, :], s, NEG_INF)
    p = jax.nn.softmax(s, axis=-1)
    return jnp.einsum('brchqk,brckhe->brcqhe', p.astype(v.dtype), vb).reshape(b, t, h, e)


def encoder_layer(x, norm_pre, w_in, b_gate, rpb, w_proj_a, w_proj_b, w_out, norm_post):
    b, t, _ = x.shape
    hn = rms_norm(x, norm_pre)
    proj = hn @ w_in
    qa, ka, va, za, qb, kb, vb, zb, ga, gb = jnp.split(proj, SPLIT_POINTS, axis=-1)
    qa = qa.reshape(b, t, N_HEADS_A, HEAD_DIM)
    ka = ka.reshape(b, t, N_HEADS_A, HEAD_DIM)
    va = va.reshape(b, t, N_HEADS_A, HEAD_DIM)
    slopes = alibi_slopes()
    outs, lses = [], []
    for g, (window, dilation) in enumerate(DIL_PATTERNS):
        sl = slice(g * HEADS_PER_GROUP_A, (g + 1) * HEADS_PER_GROUP_A)
        o, lse = dilated_window_attention(qa[:, :, sl], ka[:, :, sl], va[:, :, sl], window, dilation,
                                          slopes[g::N_GROUPS_A])
        outs.append(o)
        lses.append(lse)
    alpha = jax.nn.softmax(jnp.stack(lses, axis=0), axis=0)
    oa = jnp.concatenate([o * alpha[g][..., None].astype(o.dtype) for g, o in enumerate(outs)], axis=2)
    ya = (oa.reshape(b, t, WIDTH_A) * jax.nn.silu(za)) @ w_proj_a
    ob = neighbourhood_attention(qb.reshape(b, t, N_HEADS_B, HEAD_DIM), kb.reshape(b, t, N_HEADS_B, HEAD_DIM),
                                 vb.reshape(b, t, N_HEADS_B, HEAD_DIM), rpb)
    yb = (ob.reshape(b, t, WIDTH_B) * jax.nn.silu(zb)) @ w_proj_b
    merged = jax.nn.sigmoid(ga + b_gate[0]) * ya + jax.nn.sigmoid(gb + b_gate[1]) * yb
    out = merged @ w_out
    return x + rms_norm(out, norm_post)


def setup_inputs(seed: int = 0) -> dict:
    key = jax.random.key(seed)
    ks = jax.random.split(key, 10)
    f32 = jnp.float32
    return {
        "x_prompt": jax.random.normal(ks[0], (BATCH, SEQ, D_MODEL), f32),
        "x_sample": jax.random.normal(ks[1], (DEC_BATCH, DEC_SEQ, D_MODEL), f32),
        "norm_pre": 1.0 + 0.1 * jax.random.normal(ks[2], (DEPTH, D_MODEL), f32),
        "w_in": jax.random.normal(ks[3], (DEPTH, D_MODEL, IN_COLS), f32) * D_MODEL ** -0.5,
        "b_gate": 0.1 * jax.random.normal(ks[4], (DEPTH, 2, D_MODEL), f32),
        "rpb": 0.1 * jax.random.normal(ks[5], (DEPTH, N_HEADS_B, 2 * NA_KH - 1, 2 * NA_KW - 1), f32),
        "w_proj_a": jax.random.normal(ks[6], (DEPTH, WIDTH_A, D_MODEL), f32) * WIDTH_A ** -0.5,
        "w_proj_b": jax.random.normal(ks[7], (DEPTH, WIDTH_B, D_MODEL), f32) * WIDTH_B ** -0.5,
        "w_out": jax.random.normal(ks[8], (DEPTH, D_MODEL, D_MODEL), f32) * D_MODEL ** -0.5,
        "norm_post": 1.0 + 0.1 * jax.random.normal(ks[9], (DEPTH, D_MODEL), f32),
    }


def reference(x_prompt, x_sample, norm_pre, w_in, b_gate, rpb, w_proj_a, w_proj_b, w_out, norm_post):
    y_prompt = x_prompt
    y_sample = x_sample
    for l in range(DEPTH):
        y_prompt = encoder_layer(y_prompt, norm_pre[l], w_in[l], b_gate[l], rpb[l], w_proj_a[l], w_proj_b[l],
                                 w_out[l], norm_post[l])
        y_sample = encoder_layer(y_sample, norm_pre[l], w_in[l], b_gate[l], rpb[l], w_proj_a[l], w_proj_b[l],
                                 w_out[l], norm_post[l])
    return (y_prompt, y_sample)
```

```cpp
#include <hip/hip_runtime.h>
#include <hip/hip_cooperative_groups.h>
#include <cstdio>
#include <cstdint>
namespace cg = cooperative_groups;

constexpr int DM = 1024, SEQ = 2048, NSEQ = 48, MTOT = NSEQ * SEQ;
constexpr int SLAB_SEQ = 16, MS = SLAB_SEQ * SEQ, NSLAB = NSEQ / SLAB_SEQ;
constexpr int WA = 1152, WB = 896, INC = 10240, GW = WA + WB;
constexpr int C_QA = 0, C_KA = 1152, C_VA = 2304, C_ZA = 3456, C_QB = 4608, C_KB = 5504, C_VB = 6400, C_ZB = 7296, C_GA = 8192, C_GB = 9216;
constexpr int NHA = 18, NHB = 14;
constexpr float LOG2E = 1.4426950408889634f;
constexpr float QSCALE = 0.125f * LOG2E;
constexpr float RMS_EPS = 1e-6f;

namespace pg8 {
#define PG8_LAS __attribute__((address_space(3)))
typedef unsigned short bf16_t;
typedef short bf16x8 __attribute__((ext_vector_type(8)));
typedef float f32x4 __attribute__((ext_vector_type(4)));
typedef unsigned u32x4 __attribute__((ext_vector_type(4)));
constexpr int BM = 256, BK = 64, HALF = 128, HTB = HALF * BK * 2, STAGE_BYTES = 8 * HTB, NXCD = 8, WGM = 8;

__host__ __device__ __forceinline__ int lds_byte(int r, int c) { const int st = (r >> 4) * 2 + (c >> 5), rr = r & 15, cc = c & 31, ob = rr * 64 + cc * 2; return st * 1024 + (ob ^ (((ob >> 9) & 1) << 5)); }
__host__ __device__ __forceinline__ void stage_rc(int b, int& R, int& C) { const int st = b / 1024, sb = b % 1024, swz = sb ^ (((sb >> 9) & 1) << 5); R = (st >> 1) * 16 + swz / 64; C = (st & 1) * 32 + (swz % 64) / 2; }
__host__ __device__ __forceinline__ int perm32(int rho) { const int n = rho >> 4, i = rho & 15; return 8 * (i >> 2) + 4 * n + (i & 3); }

struct Unit { int pm, pn; };
struct Gemm { const bf16_t* A; const bf16_t* Bt; int M, N, K; };

struct StaticOrder {
    int nM, nN, nwg, G, c;
    __host__ __device__ void init(int M, int N, int G_, int c_) { nM = M / BM; nN = N / BM; nwg = nM * nN; G = G_; c = c_; }
    __host__ __device__ bool next(int i, Unit& u) const {
        const long L = (long)i * G + c; if (L >= nwg) return false;
        int wgid = (int)L; { const int q = nwg / NXCD, r = nwg % NXCD, xcd = wgid % NXCD, off = wgid / NXCD; wgid = (xcd < r ? xcd * (q + 1) : r * (q + 1) + (xcd - r) * q) + off; }
        const int nig = WGM * nN, gid = wgid / nig, fm = gid * WGM, gsz = (nM - fm) < WGM ? (nM - fm) : WGM;
        u.pm = fm + ((wgid % nig) % gsz); u.pn = (wgid % nig) / gsz; return true;
    }
};

__device__ __forceinline__ unsigned cvt_pk_bf16(float lo, float hi) { unsigned r; asm volatile("v_cvt_pk_bf16_f32 %0, %1, %2" : "=v"(r) : "v"(lo), "v"(hi)); return r; }
__device__ __forceinline__ float bf_lo(unsigned u) { return __uint_as_float(u << 16); }
__device__ __forceinline__ float bf_hi(unsigned u) { return __uint_as_float(u & 0xffff0000u); }
__device__ __forceinline__ float sigmoidf_(float x) { return __builtin_amdgcn_rcpf(1.0f + __builtin_amdgcn_exp2f(-x * LOG2E)); }

struct EpiProj {
    static constexpr bool PERM = true, HOOK = false; static constexpr int HOOK_T = -1;
    bf16_t* O; const float* bgate;
    __device__ __forceinline__ void mid(f32x4 (&acc)[2][2][4][2], const Unit& u, int wr, int wc, int fr, int fq) const {}
    __device__ __forceinline__ void operator()(const f32x4 (&acc)[2][2][4][2], const Unit& u, int wr, int wc, int fr, int fq) const {
        const int row0 = u.pm * BM + wr * 64 + fr; const int col0 = u.pn * BM + wc * 32 + 8 * fq;
        const bool gate = u.pn >= 32;
        f32x4 bv[2][2];
#pragma unroll
        for (int bj = 0; bj < 2; ++bj)
#pragma unroll
            for (int n = 0; n < 2; ++n) bv[bj][n] = gate ? *(const f32x4*)(bgate + (col0 - C_GA) + bj * HALF + 4 * n) : (f32x4){0.f, 0.f, 0.f, 0.f};
#pragma unroll
        for (int ai = 0; ai < 2; ++ai)
#pragma unroll
            for (int m = 0; m < 4; ++m) { bf16_t* rowp = O + (size_t)(row0 + ai * HALF + m * 16) * INC + col0;
#pragma unroll
                for (int bj = 0; bj < 2; ++bj) { f32x4 v0 = acc[ai][bj][m][0], v1 = acc[ai][bj][m][1];
                    if (gate) { v0 = v0 + bv[bj][0]; v1 = v1 + bv[bj][1];
#pragma unroll
                        for (int e = 0; e < 4; ++e) { v0[e] = sigmoidf_(v0[e]); v1[e] = sigmoidf_(v1[e]); } }
                    u32x4 w; w.x = cvt_pk_bf16(v0[0], v0[1]); w.y = cvt_pk_bf16(v0[2], v0[3]); w.z = cvt_pk_bf16(v1[0], v1[1]); w.w = cvt_pk_bf16(v1[2], v1[3]);
                    *(u32x4*)(rowp + bj * HALF) = w; } }
    }
};
struct EpiGate {
    static constexpr bool PERM = true, HOOK = true; static constexpr int HOOK_T = WA / BK;
    const bf16_t* P; bf16_t* O;
    __device__ __forceinline__ void mid(f32x4 (&acc)[2][2][4][2], const Unit& u, int wr, int wc, int fr, int fq) const {
        int z = 0; asm volatile("" : "+v"(z));
        const unsigned off0 = (unsigned)(((u.pm * BM + wr * 64 + fr + z) * INC + u.pn * BM + wc * 32 + 8 * fq) * 2);
        const char* pb = (const char*)P;
#pragma unroll
        for (int ai = 0; ai < 2; ++ai)
#pragma unroll
            for (int m = 0; m < 4; ++m) { const unsigned off = off0 + (unsigned)((ai * HALF + m * 16) * INC * 2);
#pragma unroll
                for (int bj = 0; bj < 2; ++bj) {
                    const u32x4 a = *(const u32x4*)(pb + off + (C_GA + bj * HALF) * 2), b = *(const u32x4*)(pb + off + (C_GB + bj * HALF) * 2);
                    f32x4 r0, r1;
                    r0[0] = bf_lo(a.x) * __builtin_amdgcn_rcpf(bf_lo(b.x)); r0[1] = bf_hi(a.x) * __builtin_amdgcn_rcpf(bf_hi(b.x));
                    r0[2] = bf_lo(a.y) * __builtin_amdgcn_rcpf(bf_lo(b.y)); r0[3] = bf_hi(a.y) * __builtin_amdgcn_rcpf(bf_hi(b.y));
                    r1[0] = bf_lo(a.z) * __builtin_amdgcn_rcpf(bf_lo(b.z)); r1[1] = bf_hi(a.z) * __builtin_amdgcn_rcpf(bf_hi(b.z));
                    r1[2] = bf_lo(a.w) * __builtin_amdgcn_rcpf(bf_lo(b.w)); r1[3] = bf_hi(a.w) * __builtin_amdgcn_rcpf(bf_hi(b.w));
                    acc[ai][bj][m][0] = acc[ai][bj][m][0] * r0; acc[ai][bj][m][1] = acc[ai][bj][m][1] * r1; }
                asm volatile("" ::: "memory"); }
    }
    __device__ __forceinline__ void operator()(const f32x4 (&acc)[2][2][4][2], const Unit& u, int wr, int wc, int fr, int fq) const {
        const int row0 = u.pm * BM + wr * 64 + fr; const int col0 = u.pn * BM + wc * 32 + 8 * fq;
#pragma unroll
        for (int ai = 0; ai < 2; ++ai)
#pragma unroll
            for (int m = 0; m < 4; ++m) { const size_t row = (size_t)(row0 + ai * HALF + m * 16); const bf16_t* gp = P + row * INC + C_GB + col0; bf16_t* op = O + row * DM + col0;
#pragma unroll
                for (int bj = 0; bj < 2; ++bj) { const u32x4 b = *(const u32x4*)(gp + bj * HALF);
                    const f32x4 v0 = acc[ai][bj][m][0], v1 = acc[ai][bj][m][1];
                    u32x4 w; w.x = cvt_pk_bf16(v0[0] * bf_lo(b.x), v0[1] * bf_hi(b.x)); w.y = cvt_pk_bf16(v0[2] * bf_lo(b.y), v0[3] * bf_hi(b.y));
                    w.z = cvt_pk_bf16(v1[0] * bf_lo(b.z), v1[1] * bf_hi(b.z)); w.w = cvt_pk_bf16(v1[2] * bf_lo(b.w), v1[3] * bf_hi(b.w));
                    *(u32x4*)(op + bj * HALF) = w; } }
    }
};
struct EpiOut {
    static constexpr bool PERM = true, HOOK = false; static constexpr int HOOK_T = -1;
    float* T; float* ss;
    __device__ __forceinline__ void mid(f32x4 (&acc)[2][2][4][2], const Unit& u, int wr, int wc, int fr, int fq) const {}
    __device__ __forceinline__ void operator()(const f32x4 (&acc)[2][2][4][2], const Unit& u, int wr, int wc, int fr, int fq) const {
        const int row0 = u.pm * BM + wr * 64 + fr; const int col0 = u.pn * BM + wc * 32 + 8 * fq;
#pragma unroll
        for (int ai = 0; ai < 2; ++ai)
#pragma unroll
            for (int m = 0; m < 4; ++m) { const size_t row = (size_t)(row0 + ai * HALF + m * 16); float* op = T + row * DM + col0; float s = 0.f;
#pragma unroll
                for (int bj = 0; bj < 2; ++bj) { const f32x4 v0 = acc[ai][bj][m][0], v1 = acc[ai][bj][m][1];
                    s += (v0[0] * v0[0] + v0[1] * v0[1]) + (v0[2] * v0[2] + v0[3] * v0[3]) + (v1[0] * v1[0] + v1[1] * v1[1]) + (v1[2] * v1[2] + v1[3] * v1[3]);
                    *(f32x4*)(op + bj * HALF) = v0; *(f32x4*)(op + bj * HALF + 4) = v1; }
                s += __shfl_xor(s, 16); s += __shfl_xor(s, 32);
                if (fq == 0) atomicAdd(ss + row, s); }
    }
};

template <class Epi, class Sched, bool ALIGN_EPI = true>
__device__ __forceinline__ void gemm_phase(PG8_LAS unsigned char* lds, const Gemm g, const Sched& S, const Epi& E) {
    int tid = threadIdx.x; asm volatile("" : "+v"(tid));
    const int wid = __builtin_amdgcn_readfirstlane(tid >> 6), lane = tid & 63, wr = wid >> 2, wc = wid & 3, fr = lane & 15, fq = lane >> 4;
    const int K = g.K, nt = K / BK;
    unsigned voffA[2], voffB[2];
#pragma unroll
    for (int i = 0; i < 2; ++i) { int R, C; stage_rc(tid * 16 + i * 8192, R, C); const int Rb = Epi::PERM ? ((R & ~31) + perm32(R & 31)) : R;
        voffA[i] = (unsigned)(R * K + C) * 2u; voffB[i] = (unsigned)(Rb * K + C) * 2u; }
    const size_t kstep = (size_t)(BK * 2);
    const size_t hstep = (size_t)HALF * K * 2;
    const size_t tstep = 2 * hstep;
    const unsigned ldsw = (unsigned)wid * 1024u;
    const int aoff = lds_byte(wr * 64 + fr, fq * 8), boff = lds_byte(wc * 32 + fr, fq * 8);
#define PG8_SA(b, h) (((b) * 2 + (h)) * HTB)
#define PG8_SB(b, h) ((4 + (b) * 2 + (h)) * HTB)
#define PG8_STAGE(bufoff, gbase, voff) do { _Pragma("unroll") for (int _i = 0; _i < 2; ++_i) \
        __builtin_amdgcn_global_load_lds((const unsigned*)((const char*)(gbase) + (voff)[_i]), (PG8_LAS unsigned*)(lds + (bufoff) + ldsw + _i * 8192), 16, 0, 0); } while (0)
#define PG8_LDA(dst, b, h) do { _Pragma("unroll") for (int m = 0; m < 4; ++m) _Pragma("unroll") for (int k = 0; k < 2; ++k) dst[m][k] = *(const PG8_LAS bf16x8*)(lds + PG8_SA(b, h) + aoff + m * 2048 + k * 1024); } while (0)
#define PG8_LDB(dst, b, h) do { _Pragma("unroll") for (int n = 0; n < 2; ++n) _Pragma("unroll") for (int k = 0; k < 2; ++k) dst[n][k] = *(const PG8_LAS bf16x8*)(lds + PG8_SB(b, h) + boff + n * 2048 + k * 1024); } while (0)
#define PG8_MMA(ai, bj, At, Bt) do { __builtin_amdgcn_s_setprio(1); _Pragma("unroll") for (int m = 0; m < 4; ++m) _Pragma("unroll") for (int n = 0; n < 2; ++n) _Pragma("unroll") for (int k = 0; k < 2; ++k) \
        acc[ai][bj][m][n] = __builtin_amdgcn_mfma_f32_16x16x32_bf16(Bt[n][k], At[m][k], acc[ai][bj][m][n], 0, 0, 0); __builtin_amdgcn_s_setprio(0); } while (0)
#define PG8_WAIT_V(n) asm volatile("s_waitcnt vmcnt(" #n ")" ::: "memory")
#define PG8_WAIT_L(n) asm volatile("s_waitcnt lgkmcnt(" #n ")" ::: "memory")
#define PG8_BAR __builtin_amdgcn_s_barrier()
#define PG8_SCHED __builtin_amdgcn_sched_barrier(0)
    Unit cur, nxt; int ui = 0;
    if (!S.next(0, cur)) return;
    f32x4 acc[2][2][4][2];
#pragma unroll
    for (int a = 0; a < 2; ++a)
#pragma unroll
        for (int b = 0; b < 2; ++b)
#pragma unroll
            for (int m = 0; m < 4; ++m)
#pragma unroll
                for (int n = 0; n < 2; ++n) acc[a][b][m][n] = (f32x4){0.f, 0.f, 0.f, 0.f};
    bf16x8 At[4][2], B0[2][2], B1[2][2];
    const char* cA = (const char*)g.A + (size_t)cur.pm * tstep; const char* cB = (const char*)g.Bt + (size_t)cur.pn * tstep;
    PG8_STAGE(PG8_SB(0, 0), cB, voffB); PG8_STAGE(PG8_SB(0, 1), cB + hstep, voffB); PG8_STAGE(PG8_SA(0, 0), cA, voffA); PG8_STAGE(PG8_SA(0, 1), cA + hstep, voffA);
    if (wr == 1) PG8_BAR;
    PG8_WAIT_V(2); PG8_BAR;
    PG8_STAGE(PG8_SB(1, 0), cB + kstep, voffB); PG8_STAGE(PG8_SA(1, 0), cA + kstep, voffA); PG8_STAGE(PG8_SB(1, 1), cB + hstep + kstep, voffB);
    PG8_WAIT_V(6); PG8_BAR;
    for (;;) {
        const bool has_next = S.next(ui + 1, nxt);
        const char* nA = has_next ? (const char*)g.A + (size_t)nxt.pm * tstep : cA; const char* nB = has_next ? (const char*)g.Bt + (size_t)nxt.pn * tstep : cB;
        for (int t = 0; t < nt; t += 2) {
            const bool last = (t == nt - 2);
            const char* a1 = cA + (size_t)(t + 1) * kstep;
            const char* a2 = last ? nA : cA + (size_t)(t + 2) * kstep; const char* b2 = last ? nB : cB + (size_t)(t + 2) * kstep;
            const char* a3 = a2 + kstep; const char* b3 = b2 + kstep;
            if constexpr (Epi::HOOK) { if (t == Epi::HOOK_T) { E.mid(acc, cur, wr, wc, fr, fq); PG8_WAIT_V(0); PG8_SCHED; } }
            PG8_LDB(B0, 0, 0); PG8_LDB(B1, 0, 1); PG8_SCHED; PG8_LDA(At, 0, 0); PG8_STAGE(PG8_SA(1, 1), a1 + hstep, voffA);
            PG8_WAIT_V(8); PG8_WAIT_L(0); PG8_BAR; PG8_MMA(0, 0, At, B0); PG8_MMA(0, 1, At, B1); PG8_BAR; PG8_SCHED;
            PG8_LDA(At, 0, 1); PG8_STAGE(PG8_SB(0, 0), b2, voffB); PG8_STAGE(PG8_SB(0, 1), b2 + hstep, voffB); PG8_STAGE(PG8_SA(0, 0), a2, voffA);
            PG8_WAIT_V(8); PG8_WAIT_L(0); PG8_BAR; PG8_MMA(1, 0, At, B0); PG8_MMA(1, 1, At, B1); PG8_BAR; PG8_SCHED;
            PG8_LDB(B0, 1, 0); PG8_LDB(B1, 1, 1); PG8_SCHED; PG8_LDA(At, 1, 0); PG8_STAGE(PG8_SA(0, 1), a2 + hstep, voffA);
            PG8_WAIT_V(8); PG8_WAIT_L(0); PG8_BAR; PG8_MMA(0, 0, At, B0); PG8_MMA(0, 1, At, B1); PG8_BAR; PG8_SCHED;
            PG8_LDA(At, 1, 1); PG8_STAGE(PG8_SB(1, 0), b3, voffB); PG8_STAGE(PG8_SB(1, 1), b3 + hstep, voffB); PG8_STAGE(PG8_SA(1, 0), a3, voffA);
            PG8_WAIT_V(8); PG8_WAIT_L(0); PG8_BAR; PG8_MMA(1, 0, At, B0); PG8_MMA(1, 1, At, B1); PG8_BAR; PG8_SCHED;
        }
        if constexpr (ALIGN_EPI) { if (wr == 0) PG8_BAR; }
        E(acc, cur, wr, wc, fr, fq);
        if (!has_next) break;
#pragma unroll
        for (int a = 0; a < 2; ++a)
#pragma unroll
            for (int b = 0; b < 2; ++b)
#pragma unroll
                for (int m = 0; m < 4; ++m)
#pragma unroll
                    for (int n = 0; n < 2; ++n) acc[a][b][m][n] = (f32x4){0.f, 0.f, 0.f, 0.f};
        cur = nxt; cA = nA; cB = nB; ++ui;
        if constexpr (ALIGN_EPI) { if (wr == 1) PG8_BAR; }
    }
    PG8_WAIT_V(0);
    if constexpr (!ALIGN_EPI) { if (wr == 0) PG8_BAR; }
    PG8_BAR;
#undef PG8_SA
#undef PG8_SB
#undef PG8_STAGE
#undef PG8_LDA
#undef PG8_LDB
#undef PG8_MMA
#undef PG8_WAIT_V
#undef PG8_WAIT_L
#undef PG8_BAR
#undef PG8_SCHED
}
}

constexpr int NWAVES = 8, NTHR = NWAVES * 64;
constexpr size_t MiB = 1u << 20;
constexpr size_t WS_CTL = 0, CTL_ZERO_BYTES = 1 * MiB;
constexpr size_t WS_WIN = 2 * MiB, WS_WAB = 22 * MiB, WS_WOUT = 26 * MiB, WS_SS = 28 * MiB, WS_LSE = 29 * MiB;
constexpr size_t WS_XN = 32 * MiB, WS_PROJ = 96 * MiB, WS_G = 736 * MiB, WS_MG = 864 * MiB, WS_END = 928 * MiB;
static_assert(WS_XN + (size_t)MS * DM * 2 <= WS_PROJ && WS_PROJ + (size_t)MS * INC * 2 <= WS_G && WS_G + (size_t)MS * GW * 2 <= WS_MG && WS_MG + (size_t)MS * DM * 2 <= WS_END, "d_ws map");
static_assert(WS_LSE + (size_t)MS * NHA * 4 <= WS_XN, "lse map");
constexpr int LDS_BYTES = 147456;

#define LAS __attribute__((address_space(3)))
typedef unsigned short bf16;
typedef unsigned v4u __attribute__((ext_vector_type(4)));
typedef float f32x4 __attribute__((ext_vector_type(4)));
#define LDS_WAIT() asm volatile("s_waitcnt lgkmcnt(0)" ::: "memory")
__device__ __forceinline__ unsigned f2bf(float f) { unsigned u = __builtin_bit_cast(unsigned, f); return (u + 0x7fffu + ((u >> 16) & 1u)) >> 16; }
__device__ __forceinline__ unsigned pk2(float lo, float hi) { return f2bf(lo) | (f2bf(hi) << 16); }
__device__ __forceinline__ float bflo(unsigned u) { return __uint_as_float(u << 16); }
__device__ __forceinline__ float bfhi(unsigned u) { return __uint_as_float(u & 0xffff0000u); }
__device__ __forceinline__ float wave_sum(float v) {
#pragma unroll
    for (int o = 1; o < 64; o <<= 1) v += __shfl_xor(v, o);
    return v;
}

__device__ __forceinline__ void p0_transpose_item(const float* W, int K, int N, bf16* WT, int ldt, int koff, bool win, LAS float* scr, int item, int lane) {
    const int nblk = N / 32, kb = item / nblk, nb = item % nblk, k0 = 64 * kb, n0 = 32 * nb;
    const float sc = (win && ((n0 < C_KA) || (n0 >= C_QB && n0 < C_KB))) ? QSCALE : 1.0f;
#pragma unroll 8
    for (int i = 0; i < 32; ++i) { const int kk = 2 * i + (lane >> 5); scr[kk * 33 + (lane & 31)] = W[(size_t)(k0 + kk) * N + n0 + (lane & 31)] * sc; }
    LDS_WAIT(); asm volatile("" ::: "memory");
    const int c = lane & 7;
#pragma unroll
    for (int j = 0; j < 4; ++j) { const int n = (lane >> 3) + 8 * j; const LAS float* s = scr + (8 * c) * 33 + n;
        v4u o; o.x = pk2(s[0 * 33], s[1 * 33]); o.y = pk2(s[2 * 33], s[3 * 33]); o.z = pk2(s[4 * 33], s[5 * 33]); o.w = pk2(s[6 * 33], s[7 * 33]);
        *(v4u*)(WT + (size_t)(n0 + n) * ldt + koff + k0 + 8 * c) = o; }
    LDS_WAIT(); asm volatile("" ::: "memory");
}
__device__ __forceinline__ void rms_row_to_bf16(const float* xrow, const float* g, bf16* orow, int lane) {
    const f32x4* xr = (const f32x4*)xrow + lane; const f32x4* gr = (const f32x4*)g + lane;
    f32x4 v[4]; float s = 0.f;
#pragma unroll
    for (int j = 0; j < 4; ++j) { v[j] = xr[64 * j]; s += (v[j].x * v[j].x + v[j].y * v[j].y) + (v[j].z * v[j].z + v[j].w * v[j].w); }
    const float rstd = 1.f / sqrtf(wave_sum(s) * (1.f / DM) + RMS_EPS);
    unsigned long long* o8 = (unsigned long long*)orow + lane;
#pragma unroll
    for (int j = 0; j < 4; ++j) { const f32x4 gg = gr[64 * j];
        o8[64 * j] = (unsigned long long)pk2(v[j].x * rstd * gg.x, v[j].y * rstd * gg.y) | ((unsigned long long)pk2(v[j].z * rstd * gg.z, v[j].w * rstd * gg.w) << 32); }
}

__device__ __forceinline__ void ld_row64(const bf16* p, float (&f)[64]) {
#pragma unroll
    for (int c = 0; c < 8; ++c) { const v4u w = *(const v4u*)(p + 8 * c);
        f[8 * c + 0] = bflo(w.x); f[8 * c + 1] = bfhi(w.x); f[8 * c + 2] = bflo(w.y); f[8 * c + 3] = bfhi(w.y);
        f[8 * c + 4] = bflo(w.z); f[8 * c + 5] = bfhi(w.z); f[8 * c + 6] = bflo(w.w); f[8 * c + 7] = bfhi(w.w); }
}
__device__ __forceinline__ float dot_row64(const bf16* p, const float (&q)[64]) {
    float s0 = 0.f, s1 = 0.f;
#pragma unroll
    for (int c = 0; c < 8; ++c) { const v4u w = *(const v4u*)(p + 8 * c);
        s0 += q[8 * c + 0] * bflo(w.x); s1 += q[8 * c + 1] * bfhi(w.x); s0 += q[8 * c + 2] * bflo(w.y); s1 += q[8 * c + 3] * bfhi(w.y);
        s0 += q[8 * c + 4] * bflo(w.z); s1 += q[8 * c + 5] * bfhi(w.z); s0 += q[8 * c + 6] * bflo(w.w); s1 += q[8 * c + 7] * bfhi(w.w); }
    return s0 + s1;
}
__device__ __forceinline__ void axpy_row64(const bf16* p, float a, float (&o)[64]) {
#pragma unroll
    for (int c = 0; c < 8; ++c) { const v4u w = *(const v4u*)(p + 8 * c);
        o[8 * c + 0] += a * bflo(w.x); o[8 * c + 1] += a * bfhi(w.x); o[8 * c + 2] += a * bflo(w.y); o[8 * c + 3] += a * bfhi(w.y);
        o[8 * c + 4] += a * bflo(w.z); o[8 * c + 5] += a * bfhi(w.z); o[8 * c + 6] += a * bflo(w.w); o[8 * c + 7] += a * bfhi(w.w); }
}
__device__ __forceinline__ float siluf_(float x) { return x * __builtin_amdgcn_rcpf(1.0f + __builtin_amdgcn_exp2f(-x * LOG2E)); }

__device__ __forceinline__ void naive_attn_a(const bf16* P, bf16* G, float* LSE, long gtid, long nthr) {
    for (long idx = gtid; idx < (long)MS * NHA; idx += nthr) {
        const int hA = (int)(idx / MS), row = (int)(idx % MS), g = hA / 6, j = hA % 6;
        const int d = (g == 0) ? 1 : (g == 1 ? 4 : 16), L = SEQ / d;
        const int sb = row / SEQ, t = row % SEQ, mq = t / d, r = t % d;
        const float slope = exp2f(-8.0f * (float)(g + 3 * j + 1) / 18.0f) * LOG2E * (float)d;
        float q[64], o[64];
        ld_row64(P + (size_t)row * INC + C_QA + hA * 64, q);
#pragma unroll
        for (int e = 0; e < 64; ++e) o[e] = 0.f;
        float m = -1e30f, l = 0.f;
        const int lo = mq - 64 < 0 ? 0 : mq - 64, hi = mq + 64 > L - 1 ? L - 1 : mq + 64;
        for (int mk = lo; mk <= hi; ++mk) {
            const size_t krow = (size_t)(sb * SEQ + mk * d + r);
            const int off = mk > mq ? mk - mq : mq - mk;
            const float s = dot_row64(P + krow * INC + C_KA + hA * 64, q) - slope * (float)off;
            const float mn = fmaxf(m, s), cr = __builtin_amdgcn_exp2f(m - mn), p = __builtin_amdgcn_exp2f(s - mn);
            l = l * cr + p; m = mn;
#pragma unroll
            for (int e = 0; e < 64; ++e) o[e] *= cr;
            axpy_row64(P + krow * INC + C_VA + hA * 64, p, o);
        }
        const float rl = 1.0f / l;
        bf16* op = G + (size_t)row * GW + hA * 64;
#pragma unroll
        for (int c = 0; c < 8; ++c) { v4u w; w.x = pk2(o[8 * c] * rl, o[8 * c + 1] * rl); w.y = pk2(o[8 * c + 2] * rl, o[8 * c + 3] * rl); w.z = pk2(o[8 * c + 4] * rl, o[8 * c + 5] * rl); w.w = pk2(o[8 * c + 6] * rl, o[8 * c + 7] * rl); *(v4u*)(op + 8 * c) = w; }
        LSE[(size_t)row * NHA + hA] = m + log2f(l);
    }
}
__device__ __forceinline__ void naive_attn_b(const bf16* P, bf16* G, const float* rpb, long gtid, long nthr) {
    for (long idx = gtid; idx < (long)MS * NHB; idx += nthr) {
        const int h = (int)(idx / MS), row = (int)(idx % MS);
        const int sb = row / SEQ, t = row % SEQ, r = t / 64, c = t % 64;
        const int rs = r - 4 < 0 ? 0 : (r - 4 > 24 ? 24 : r - 4), cs = c - 8 < 0 ? 0 : (c - 8 > 48 ? 48 : c - 8);
        float q[64], o[64];
        ld_row64(P + (size_t)row * INC + C_QB + h * 64, q);
#pragma unroll
        for (int e = 0; e < 64; ++e) o[e] = 0.f;
        float m = -1e30f, l = 0.f;
        for (int kk = 0; kk < 128; ++kk) {
            const int kr = rs + (kk >> 4), kc = cs + (kk & 15);
            const size_t krow = (size_t)(sb * SEQ + kr * 64 + kc);
            const float bias = rpb[(h * 15 + (kr - r + 7)) * 31 + (kc - c + 15)] * LOG2E;
            const float s = dot_row64(P + krow * INC + C_KB + h * 64, q) + bias;
            const float mn = fmaxf(m, s), cr = __builtin_amdgcn_exp2f(m - mn), p = __builtin_amdgcn_exp2f(s - mn);
            l = l * cr + p; m = mn;
#pragma unroll
            for (int e = 0; e < 64; ++e) o[e] *= cr;
            axpy_row64(P + krow * INC + C_VB + h * 64, p, o);
        }
        const float rl = 1.0f / l;
        float z[64]; ld_row64(P + (size_t)row * INC + C_ZB + h * 64, z);
        bf16* op = G + (size_t)row * GW + WA + h * 64;
#pragma unroll
        for (int cc = 0; cc < 8; ++cc) { v4u w;
            w.x = pk2(o[8 * cc] * rl * siluf_(z[8 * cc]), o[8 * cc + 1] * rl * siluf_(z[8 * cc + 1])); w.y = pk2(o[8 * cc + 2] * rl * siluf_(z[8 * cc + 2]), o[8 * cc + 3] * rl * siluf_(z[8 * cc + 3]));
            w.z = pk2(o[8 * cc + 4] * rl * siluf_(z[8 * cc + 4]), o[8 * cc + 5] * rl * siluf_(z[8 * cc + 5])); w.w = pk2(o[8 * cc + 6] * rl * siluf_(z[8 * cc + 6]), o[8 * cc + 7] * rl * siluf_(z[8 * cc + 7]));
            *(v4u*)(op + 8 * cc) = w; }
    }
}
__device__ __forceinline__ void combine_a(const bf16* P, bf16* G, const float* LSE, long gtid, long nthr) {
    for (long idx = gtid; idx < (long)MS * NHA * 8; idx += nthr) {
        const int c8 = (int)(idx & 7), hA = (int)((idx >> 3) % NHA), row = (int)((idx >> 3) / NHA), j = hA % 6;
        const float l0 = LSE[(size_t)row * NHA + j], l1 = LSE[(size_t)row * NHA + 6 + j], l2 = LSE[(size_t)row * NHA + 12 + j], lm = fmaxf(l0, fmaxf(l1, l2));
        const float e0 = __builtin_amdgcn_exp2f(l0 - lm), e1 = __builtin_amdgcn_exp2f(l1 - lm), e2 = __builtin_amdgcn_exp2f(l2 - lm);
        const float mine = hA < 6 ? e0 : (hA < 12 ? e1 : e2), alpha = mine / (e0 + e1 + e2);
        bf16* gp = G + (size_t)row * GW + hA * 64 + c8 * 8; const v4u o = *(const v4u*)gp, z = *(const v4u*)(P + (size_t)row * INC + C_ZA + hA * 64 + c8 * 8);
        v4u w; w.x = pk2(bflo(o.x) * alpha * siluf_(bflo(z.x)), bfhi(o.x) * alpha * siluf_(bfhi(z.x))); w.y = pk2(bflo(o.y) * alpha * siluf_(bflo(z.y)), bfhi(o.y) * alpha * siluf_(bfhi(z.y)));
        w.z = pk2(bflo(o.z) * alpha * siluf_(bflo(z.z)), bfhi(o.z) * alpha * siluf_(bfhi(z.z))); w.w = pk2(bflo(o.w) * alpha * siluf_(bflo(z.w)), bfhi(o.w) * alpha * siluf_(bfhi(z.w)));
        *(v4u*)gp = w;
    }
}

struct Args { const float* in[10]; float* out; unsigned char* ws; };
__global__ void __launch_bounds__(NTHR, 2) fwd_megakernel(Args args) {
    extern __shared__ __attribute__((aligned(16))) unsigned char lds[];
    cg::grid_group grid = cg::this_grid();
    LAS unsigned char* L = (LAS unsigned char*)lds;
    const int G = gridDim.x, bx = blockIdx.x;
    const int NGW = G * NWAVES; const long nthr = (long)G * NTHR;
#define PHASE_IDS() int tid = threadIdx.x; asm volatile("" : "+v"(tid)); const int lane = tid & 63, wave = __builtin_amdgcn_readfirstlane(tid >> 6), gw = bx * NWAVES + wave; const long gtid = (long)bx * NTHR + tid; (void)lane; (void)gw; (void)gtid
    unsigned char* ws = args.ws;
    const float *xp = args.in[0], *xs = args.in[1], *norm_pre = args.in[2], *w_in = args.in[3], *b_gate = args.in[4], *rpb = args.in[5], *w_pa = args.in[6], *w_pb = args.in[7], *w_out = args.in[8], *norm_post = args.in[9];
    bf16* WIN = (bf16*)(ws + WS_WIN); bf16* WAB = (bf16*)(ws + WS_WAB); bf16* WOUT = (bf16*)(ws + WS_WOUT);
    float* SS = (float*)(ws + WS_SS); float* LSE = (float*)(ws + WS_LSE);
    bf16* XN = (bf16*)(ws + WS_XN); bf16* PROJ = (bf16*)(ws + WS_PROJ); bf16* GB_ = (bf16*)(ws + WS_G); bf16* MG = (bf16*)(ws + WS_MG);

    {
        PHASE_IDS();
        LAS float* scr = (LAS float*)(L + wave * 16384);
        constexpr int I_IN = (DM / 64) * (INC / 32), I_A = (WA / 64) * (DM / 32), I_B = (WB / 64) * (DM / 32), I_O = (DM / 64) * (DM / 32);
        for (int it = gw; it < I_IN + I_A + I_B + I_O; it += NGW) {
            int r = it;
            if (r < I_IN) { p0_transpose_item(w_in, DM, INC, WIN, DM, 0, true, scr, r, lane); continue; } r -= I_IN;
            if (r < I_A) { p0_transpose_item(w_pa, WA, DM, WAB, GW, 0, false, scr, r, lane); continue; } r -= I_A;
            if (r < I_B) { p0_transpose_item(w_pb, WB, DM, WAB, GW, WA, false, scr, r, lane); continue; } r -= I_B;
            p0_transpose_item(w_out, DM, DM, WOUT, DM, 0, false, scr, r, lane);
        }
        for (long i = gtid; i < MTOT; i += nthr) SS[i] = 0.f;
    }
    for (int s = 0; s < NSLAB; ++s) {
        const float* xsl = (s == 0) ? xp : xs + (size_t)(s - 1) * MS * DM;
        float* osl = args.out + (size_t)s * MS * DM;
        float* sssl = SS + (size_t)s * MS;
        const bf16 *XNp = XN, *WINp = WIN, *WABp = WAB, *WOUTp = WOUT, *MGp = MG; bf16* Gp = GB_;
        asm volatile("" : "+s"(XNp), "+s"(WINp), "+s"(WABp), "+s"(WOUTp), "+s"(MGp), "+s"(Gp));
        { PHASE_IDS(); for (int m = gw; m < MS; m += NGW) rms_row_to_bf16(xsl + (size_t)m * DM, norm_pre, XN + (size_t)m * DM, lane); }
        grid.sync();
        { pg8::Gemm g{XNp, WINp, MS, INC, DM}; pg8::StaticOrder S; S.init(MS, INC, G, bx); pg8::EpiProj E{PROJ, b_gate};
          pg8::gemm_phase<pg8::EpiProj, pg8::StaticOrder>(L, g, S, E); }
        grid.sync();
        { PHASE_IDS(); naive_attn_a(PROJ, GB_, LSE, gtid, nthr); }
        { PHASE_IDS(); naive_attn_b(PROJ, GB_, rpb, gtid, nthr); }
        grid.sync();
        { PHASE_IDS(); combine_a(PROJ, GB_, LSE, gtid, nthr); }
        grid.sync();
        { pg8::Gemm g{Gp, WABp, MS, DM, GW}; pg8::StaticOrder S; S.init(MS, DM, G, bx); pg8::EpiGate E{PROJ, MG};
          pg8::gemm_phase<pg8::EpiGate, pg8::StaticOrder>(L, g, S, E); }
        grid.sync();
        { pg8::Gemm g{MGp, WOUTp, MS, DM, DM}; pg8::StaticOrder S; S.init(MS, DM, G, bx); pg8::EpiOut E{osl, sssl};
          pg8::gemm_phase<pg8::EpiOut, pg8::StaticOrder>(L, g, S, E); }
        grid.sync();
        { PHASE_IDS();
        for (int m = gw; m < MS; m += NGW) {
            const float rstd = 1.f / sqrtf(sssl[m] * (1.f / DM) + RMS_EPS);
            const f32x4* xr = (const f32x4*)(xsl + (size_t)m * DM) + lane; f32x4* tr = (f32x4*)(osl + (size_t)m * DM) + lane; const f32x4* gr = (const f32x4*)norm_post + lane;
#pragma unroll
            for (int j = 0; j < 4; ++j) { const f32x4 t = tr[64 * j], x = xr[64 * j], gg = gr[64 * j]; tr[64 * j] = x + t * rstd * gg; }
        } }
    }
}

extern "C" void kernel_launch(void* const* d_in, const int* in_sizes, int n_in, void* d_out, int out_size, void* d_ws, size_t ws_size, hipStream_t stream) {
    static int grid = 0;
    if (grid == 0) {
        if (n_in != 10 || out_size != MTOT * DM || ws_size < WS_END) { fprintf(stderr, "kernel_launch: bad shapes: n_in %d out %d ws %zu (need %zu)\n", n_in, out_size, ws_size, (size_t)WS_END); grid = -1; return; }
        int dev = 0, cus = 0, per_cu = 0;
        hipGetDevice(&dev); hipDeviceGetAttribute(&cus, hipDeviceAttributeMultiprocessorCount, dev);
        if (hipFuncSetAttribute((const void*)fwd_megakernel, hipFuncAttributeMaxDynamicSharedMemorySize, LDS_BYTES) != hipSuccess) { fprintf(stderr, "kernel_launch: hipFuncSetAttribute failed\n"); grid = -1; return; }
        hipOccupancyMaxActiveBlocksPerMultiprocessor(&per_cu, (const void*)fwd_megakernel, NTHR, LDS_BYTES);
        if (per_cu < 1) { fprintf(stderr, "kernel_launch: occupancy query says %d blocks per CU\n", per_cu); per_cu = 1; }
        (void)hipGetLastError();
        grid = cus;
    }
    if (grid < 0) return;
    Args a{};
    for (int i = 0; i < 10; ++i) a.in[i] = (const float*)d_in[i];
    a.out = (float*)d_out; a.ws = (unsigned char*)d_ws;
    void* kargs[] = {&a};
    hipError_t e = hipLaunchCooperativeKernel((const void*)fwd_megakernel, dim3(grid), dim3(NTHR), kargs, LDS_BYTES, stream);
    if (e != hipSuccess) fprintf(stderr, "cooperative launch failed: %s (grid %d)\n", hipGetErrorString(e), grid);
}
```

```cpp
#include <hip/hip_runtime.h>
#include <hip/hip_cooperative_groups.h>
#include <cstdio>
#include <cstdint>
namespace cg = cooperative_groups;

constexpr int DM = 1024, SEQ = 2048, NSEQ = 48, MTOT = NSEQ * SEQ;
constexpr int SLAB_SEQ = 16, MS = SLAB_SEQ * SEQ, NSLAB = NSEQ / SLAB_SEQ;
constexpr int WA = 1152, WB = 896, INC = 10240, GW = WA + WB;
constexpr int C_QA = 0, C_KA = 1152, C_VA = 2304, C_ZA = 3456, C_QB = 4608, C_KB = 5504, C_VB = 6400, C_ZB = 7296, C_GA = 8192, C_GB = 9216;
constexpr int NHA = 18, NHB = 14;
constexpr float LOG2E = 1.4426950408889634f;
constexpr float QSCALE = 0.125f * LOG2E;
constexpr float RMS_EPS = 1e-6f;

namespace pg8 {
#define PG8_LAS __attribute__((address_space(3)))
typedef unsigned short bf16_t;
typedef short bf16x8 __attribute__((ext_vector_type(8)));
typedef float f32x4 __attribute__((ext_vector_type(4)));
typedef unsigned u32x4 __attribute__((ext_vector_type(4)));
constexpr int BM = 256, BK = 64, HALF = 128, HTB = HALF * BK * 2, STAGE_BYTES = 8 * HTB, NXCD = 8, WGM = 8;

__host__ __device__ __forceinline__ int lds_byte(int r, int c) { const int st = (r >> 4) * 2 + (c >> 5), rr = r & 15, cc = c & 31, ob = rr * 64 + cc * 2; return st * 1024 + (ob ^ (((ob >> 9) & 1) << 5)); }
__host__ __device__ __forceinline__ void stage_rc(int b, int& R, int& C) { const int st = b / 1024, sb = b % 1024, swz = sb ^ (((sb >> 9) & 1) << 5); R = (st >> 1) * 16 + swz / 64; C = (st & 1) * 32 + (swz % 64) / 2; }
__host__ __device__ __forceinline__ int perm32(int rho) { const int n = rho >> 4, i = rho & 15; return 8 * (i >> 2) + 4 * n + (i & 3); }

struct Unit { int pm, pn; };
struct Gemm { const bf16_t* A; const bf16_t* Bt; int M, N, K; };

struct StaticOrder {
    int nM, nN, nwg, G, c;
    __host__ __device__ void init(int M, int N, int G_, int c_) { nM = M / BM; nN = N / BM; nwg = nM * nN; G = G_; c = c_; }
    __host__ __device__ bool next(int i, Unit& u) const {
        const long L = (long)i * G + c; if (L >= nwg) return false;
        int wgid = (int)L; { const int q = nwg / NXCD, r = nwg % NXCD, xcd = wgid % NXCD, off = wgid / NXCD; wgid = (xcd < r ? xcd * (q + 1) : r * (q + 1) + (xcd - r) * q) + off; }
        const int nig = WGM * nN, gid = wgid / nig, fm = gid * WGM, gsz = (nM - fm) < WGM ? (nM - fm) : WGM;
        u.pm = fm + ((wgid % nig) % gsz); u.pn = (wgid % nig) / gsz; return true;
    }
};

__device__ __forceinline__ unsigned cvt_pk_bf16(float lo, float hi) { unsigned r; asm volatile("v_cvt_pk_bf16_f32 %0, %1, %2" : "=v"(r) : "v"(lo), "v"(hi)); return r; }
__device__ __forceinline__ float bf_lo(unsigned u) { return __uint_as_float(u << 16); }
__device__ __forceinline__ float bf_hi(unsigned u) { return __uint_as_float(u & 0xffff0000u); }
__device__ __forceinline__ float sigmoidf_(float x) { return __builtin_amdgcn_rcpf(1.0f + __builtin_amdgcn_exp2f(-x * LOG2E)); }

struct EpiProj {
    static constexpr bool PERM = true, HOOK = false; static constexpr int HOOK_T = -1;
    bf16_t* O; const float* bgate;
    __device__ __forceinline__ void mid(f32x4 (&acc)[2][2][4][2], const Unit& u, int wr, int wc, int fr, int fq) const {}
    __device__ __forceinline__ void operator()(const f32x4 (&acc)[2][2][4][2], const Unit& u, int wr, int wc, int fr, int fq) const {
        const int row0 = u.pm * BM + wr * 64 + fr; const int col0 = u.pn * BM + wc * 32 + 8 * fq;
        const bool gate = u.pn >= 32;
        f32x4 bv[2][2];
#pragma unroll
        for (int bj = 0; bj < 2; ++bj)
#pragma unroll
            for (int n = 0; n < 2; ++n) bv[bj][n] = gate ? *(const f32x4*)(bgate + (col0 - C_GA) + bj * HALF + 4 * n) : (f32x4){0.f, 0.f, 0.f, 0.f};
#pragma unroll
        for (int ai = 0; ai < 2; ++ai)
#pragma unroll
            for (int m = 0; m < 4; ++m) { bf16_t* rowp = O + (size_t)(row0 + ai * HALF + m * 16) * INC + col0;
#pragma unroll
                for (int bj = 0; bj < 2; ++bj) { f32x4 v0 = acc[ai][bj][m][0], v1 = acc[ai][bj][m][1];
                    if (gate) { v0 = v0 + bv[bj][0]; v1 = v1 + bv[bj][1];
#pragma unroll
                        for (int e = 0; e < 4; ++e) { v0[e] = sigmoidf_(v0[e]); v1[e] = sigmoidf_(v1[e]); } }
                    u32x4 w; w.x = cvt_pk_bf16(v0[0], v0[1]); w.y = cvt_pk_bf16(v0[2], v0[3]); w.z = cvt_pk_bf16(v1[0], v1[1]); w.w = cvt_pk_bf16(v1[2], v1[3]);
                    *(u32x4*)(rowp + bj * HALF) = w; } }
    }
};
struct EpiGate {
    static constexpr bool PERM = true, HOOK = true; static constexpr int HOOK_T = WA / BK;
    const bf16_t* P; bf16_t* O;
    __device__ __forceinline__ void mid(f32x4 (&acc)[2][2][4][2], const Unit& u, int wr, int wc, int fr, int fq) const {
        int z = 0; asm volatile("" : "+v"(z));
        const unsigned off0 = (unsigned)(((u.pm * BM + wr * 64 + fr + z) * INC + u.pn * BM + wc * 32 + 8 * fq) * 2);
        const char* pb = (const char*)P;
#pragma unroll
        for (int ai = 0; ai < 2; ++ai)
#pragma unroll
            for (int m = 0; m < 4; ++m) { const unsigned off = off0 + (unsigned)((ai * HALF + m * 16) * INC * 2);
#pragma unroll
                for (int bj = 0; bj < 2; ++bj) {
                    const u32x4 a = *(const u32x4*)(pb + off + (C_GA + bj * HALF) * 2), b = *(const u32x4*)(pb + off + (C_GB + bj * HALF) * 2);
                    f32x4 r0, r1;
                    r0[0] = bf_lo(a.x) * __builtin_amdgcn_rcpf(bf_lo(b.x)); r0[1] = bf_hi(a.x) * __builtin_amdgcn_rcpf(bf_hi(b.x));
                    r0[2] = bf_lo(a.y) * __builtin_amdgcn_rcpf(bf_lo(b.y)); r0[3] = bf_hi(a.y) * __builtin_amdgcn_rcpf(bf_hi(b.y));
                    r1[0] = bf_lo(a.z) * __builtin_amdgcn_rcpf(bf_lo(b.z)); r1[1] = bf_hi(a.z) * __builtin_amdgcn_rcpf(bf_hi(b.z));
                    r1[2] = bf_lo(a.w) * __builtin_amdgcn_rcpf(bf_lo(b.w)); r1[3] = bf_hi(a.w) * __builtin_amdgcn_rcpf(bf_hi(b.w));
                    acc[ai][bj][m][0] = acc[ai][bj][m][0] * r0; acc[ai][bj][m][1] = acc[ai][bj][m][1] * r1; }
                asm volatile("" ::: "memory"); }
    }
    __device__ __forceinline__ void operator()(const f32x4 (&acc)[2][2][4][2], const Unit& u, int wr, int wc, int fr, int fq) const {
        const int row0 = u.pm * BM + wr * 64 + fr; const int col0 = u.pn * BM + wc * 32 + 8 * fq;
#pragma unroll
        for (int ai = 0; ai < 2; ++ai)
#pragma unroll
            for (int m = 0; m < 4; ++m) { const size_t row = (size_t)(row0 + ai * HALF + m * 16); const bf16_t* gp = P + row * INC + C_GB + col0; bf16_t* op = O + row * DM + col0;
#pragma unroll
                for (int bj = 0; bj < 2; ++bj) { const u32x4 b = *(const u32x4*)(gp + bj * HALF);
                    const f32x4 v0 = acc[ai][bj][m][0], v1 = acc[ai][bj][m][1];
                    u32x4 w; w.x = cvt_pk_bf16(v0[0] * bf_lo(b.x), v0[1] * bf_hi(b.x)); w.y = cvt_pk_bf16(v0[2] * bf_lo(b.y), v0[3] * bf_hi(b.y));
                    w.z = cvt_pk_bf16(v1[0] * bf_lo(b.z), v1[1] * bf_hi(b.z)); w.w = cvt_pk_bf16(v1[2] * bf_lo(b.w), v1[3] * bf_hi(b.w));
                    *(u32x4*)(op + bj * HALF) = w; } }
    }
};
struct EpiOut {
    static constexpr bool PERM = true, HOOK = false; static constexpr int HOOK_T = -1;
    float* T; float* ss;
    __device__ __forceinline__ void mid(f32x4 (&acc)[2][2][4][2], const Unit& u, int wr, int wc, int fr, int fq) const {}
    __device__ __forceinline__ void operator()(const f32x4 (&acc)[2][2][4][2], const Unit& u, int wr, int wc, int fr, int fq) const {
        const int row0 = u.pm * BM + wr * 64 + fr; const int col0 = u.pn * BM + wc * 32 + 8 * fq;
#pragma unroll
        for (int ai = 0; ai < 2; ++ai)
#pragma unroll
            for (int m = 0; m < 4; ++m) { const size_t row = (size_t)(row0 + ai * HALF + m * 16); float* op = T + row * DM + col0; float s = 0.f;
#pragma unroll
                for (int bj = 0; bj < 2; ++bj) { const f32x4 v0 = acc[ai][bj][m][0], v1 = acc[ai][bj][m][1];
                    s += (v0[0] * v0[0] + v0[1] * v0[1]) + (v0[2] * v0[2] + v0[3] * v0[3]) + (v1[0] * v1[0] + v1[1] * v1[1]) + (v1[2] * v1[2] + v1[3] * v1[3]);
                    *(f32x4*)(op + bj * HALF) = v0; *(f32x4*)(op + bj * HALF + 4) = v1; }
                s += __shfl_xor(s, 16); s += __shfl_xor(s, 32);
                if (fq == 0) atomicAdd(ss + row, s); }
    }
};

template <class Epi, class Sched, bool ALIGN_EPI = true>
__device__ __forceinline__ void gemm_phase(PG8_LAS unsigned char* lds, const Gemm g, const Sched& S, const Epi& E) {
    int tid = threadIdx.x; asm volatile("" : "+v"(tid));
    const int wid = __builtin_amdgcn_readfirstlane(tid >> 6), lane = tid & 63, wr = wid >> 2, wc = wid & 3, fr = lane & 15, fq = lane >> 4;
    const int K = g.K, nt = K / BK;
    unsigned voffA[2], voffB[2];
#pragma unroll
    for (int i = 0; i < 2; ++i) { int R, C; stage_rc(tid * 16 + i * 8192, R, C); const int Rb = Epi::PERM ? ((R & ~31) + perm32(R & 31)) : R;
        voffA[i] = (unsigned)(R * K + C) * 2u; voffB[i] = (unsigned)(Rb * K + C) * 2u; }
    const size_t kstep = (size_t)(BK * 2);
    const size_t hstep = (size_t)HALF * K * 2;
    const size_t tstep = 2 * hstep;
    const unsigned ldsw = (unsigned)wid * 1024u;
    const int aoff = lds_byte(wr * 64 + fr, fq * 8), boff = lds_byte(wc * 32 + fr, fq * 8);
#define PG8_SA(b, h) (((b) * 2 + (h)) * HTB)
#define PG8_SB(b, h) ((4 + (b) * 2 + (h)) * HTB)
#define PG8_STAGE(bufoff, gbase, voff) do { _Pragma("unroll") for (int _i = 0; _i < 2; ++_i) \
        __builtin_amdgcn_global_load_lds((const unsigned*)((const char*)(gbase) + (voff)[_i]), (PG8_LAS unsigned*)(lds + (bufoff) + ldsw + _i * 8192), 16, 0, 0); } while (0)
#define PG8_LDA(dst, b, h) do { _Pragma("unroll") for (int m = 0; m < 4; ++m) _Pragma("unroll") for (int k = 0; k < 2; ++k) dst[m][k] = *(const PG8_LAS bf16x8*)(lds + PG8_SA(b, h) + aoff + m * 2048 + k * 1024); } while (0)
#define PG8_LDB(dst, b, h) do { _Pragma("unroll") for (int n = 0; n < 2; ++n) _Pragma("unroll") for (int k = 0; k < 2; ++k) dst[n][k] = *(const PG8_LAS bf16x8*)(lds + PG8_SB(b, h) + boff + n * 2048 + k * 1024); } while (0)
#define PG8_MMA(ai, bj, At, Bt) do { __builtin_amdgcn_s_setprio(1); _Pragma("unroll") for (int m = 0; m < 4; ++m) _Pragma("unroll") for (int n = 0; n < 2; ++n) _Pragma("unroll") for (int k = 0; k < 2; ++k) \
        acc[ai][bj][m][n] = __builtin_amdgcn_mfma_f32_16x16x32_bf16(Bt[n][k], At[m][k], acc[ai][bj][m][n], 0, 0, 0); __builtin_amdgcn_s_setprio(0); } while (0)
#define PG8_WAIT_V(n) asm volatile("s_waitcnt vmcnt(" #n ")" ::: "memory")
#define PG8_WAIT_L(n) asm volatile("s_waitcnt lgkmcnt(" #n ")" ::: "memory")
#define PG8_BAR __builtin_amdgcn_s_barrier()
#define PG8_SCHED __builtin_amdgcn_sched_barrier(0)
    Unit cur, nxt; int ui = 0;
    if (!S.next(0, cur)) return;
    f32x4 acc[2][2][4][2];
#pragma unroll
    for (int a = 0; a < 2; ++a)
#pragma unroll
        for (int b = 0; b < 2; ++b)
#pragma unroll
            for (int m = 0; m < 4; ++m)
#pragma unroll
                for (int n = 0; n < 2; ++n) acc[a][b][m][n] = (f32x4){0.f, 0.f, 0.f, 0.f};
    bf16x8 At[4][2], B0[2][2], B1[2][2];
    const char* cA = (const char*)g.A + (size_t)cur.pm * tstep; const char* cB = (const char*)g.Bt + (size_t)cur.pn * tstep;
    PG8_STAGE(PG8_SB(0, 0), cB, voffB); PG8_STAGE(PG8_SB(0, 1), cB + hstep, voffB); PG8_STAGE(PG8_SA(0, 0), cA, voffA); PG8_STAGE(PG8_SA(0, 1), cA + hstep, voffA);
    if (wr == 1) PG8_BAR;
    PG8_WAIT_V(2); PG8_BAR;
    PG8_STAGE(PG8_SB(1, 0), cB + kstep, voffB); PG8_STAGE(PG8_SA(1, 0), cA + kstep, voffA); PG8_STAGE(PG8_SB(1, 1), cB + hstep + kstep, voffB);
    PG8_WAIT_V(6); PG8_BAR;
    for (;;) {
        const bool has_next = S.next(ui + 1, nxt);
        const char* nA = has_next ? (const char*)g.A + (size_t)nxt.pm * tstep : cA; const char* nB = has_next ? (const char*)g.Bt + (size_t)nxt.pn * tstep : cB;
        for (int t = 0; t < nt; t += 2) {
            const bool last = (t == nt - 2);
            const char* a1 = cA + (size_t)(t + 1) * kstep;
            const char* a2 = last ? nA : cA + (size_t)(t + 2) * kstep; const char* b2 = last ? nB : cB + (size_t)(t + 2) * kstep;
            const char* a3 = a2 + kstep; const char* b3 = b2 + kstep;
            if constexpr (Epi::HOOK) { if (t == Epi::HOOK_T) { E.mid(acc, cur, wr, wc, fr, fq); PG8_WAIT_V(0); PG8_SCHED; } }
            PG8_LDB(B0, 0, 0); PG8_LDB(B1, 0, 1); PG8_SCHED; PG8_LDA(At, 0, 0); PG8_STAGE(PG8_SA(1, 1), a1 + hstep, voffA);
            PG8_WAIT_V(8); PG8_WAIT_L(0); PG8_BAR; PG8_MMA(0, 0, At, B0); PG8_MMA(0, 1, At, B1); PG8_BAR; PG8_SCHED;
            PG8_LDA(At, 0, 1); PG8_STAGE(PG8_SB(0, 0), b2, voffB); PG8_STAGE(PG8_SB(0, 1), b2 + hstep, voffB); PG8_STAGE(PG8_SA(0, 0), a2, voffA);
            PG8_WAIT_V(8); PG8_WAIT_L(0); PG8_BAR; PG8_MMA(1, 0, At, B0); PG8_MMA(1, 1, At, B1); PG8_BAR; PG8_SCHED;
            PG8_LDB(B0, 1, 0); PG8_LDB(B1, 1, 1); PG8_SCHED; PG8_LDA(At, 1, 0); PG8_STAGE(PG8_SA(0, 1), a2 + hstep, voffA);
            PG8_WAIT_V(8); PG8_WAIT_L(0); PG8_BAR; PG8_MMA(0, 0, At, B0); PG8_MMA(0, 1, At, B1); PG8_BAR; PG8_SCHED;
            PG8_LDA(At, 1, 1); PG8_STAGE(PG8_SB(1, 0), b3, voffB); PG8_STAGE(PG8_SB(1, 1), b3 + hstep, voffB); PG8_STAGE(PG8_SA(1, 0), a3, voffA);
            PG8_WAIT_V(8); PG8_WAIT_L(0); PG8_BAR; PG8_MMA(1, 0, At, B0); PG8_MMA(1, 1, At, B1); PG8_BAR; PG8_SCHED;
        }
        if constexpr (ALIGN_EPI) { if (wr == 0) PG8_BAR; }
        E(acc, cur, wr, wc, fr, fq);
        if (!has_next) break;
#pragma unroll
        for (int a = 0; a < 2; ++a)
#pragma unroll
            for (int b = 0; b < 2; ++b)
#pragma unroll
                for (int m = 0; m < 4; ++m)
#pragma unroll
                    for (int n = 0; n < 2; ++n) acc[a][b][m][n] = (f32x4){0.f, 0.f, 0.f, 0.f};
        cur = nxt; cA = nA; cB = nB; ++ui;
        if constexpr (ALIGN_EPI) { if (wr == 1) PG8_BAR; }
    }
    PG8_WAIT_V(0);
    if constexpr (!ALIGN_EPI) { if (wr == 0) PG8_BAR; }
    PG8_BAR;
#undef PG8_SA
#undef PG8_SB
#undef PG8_STAGE
#undef PG8_LDA
#undef PG8_LDB
#undef PG8_MMA
#undef PG8_WAIT_V
#undef PG8_WAIT_L
#undef PG8_BAR
#undef PG8_SCHED
}
}

constexpr int NWAVES = 8, NTHR = NWAVES * 64;
constexpr size_t MiB = 1u << 20;
constexpr size_t WS_CTL = 0, CTL_ZERO_BYTES = 1 * MiB;
constexpr size_t WS_WIN = 2 * MiB, WS_WAB = 22 * MiB, WS_WOUT = 26 * MiB, WS_SS = 28 * MiB, WS_LSE = 29 * MiB;
constexpr size_t WS_XN = 32 * MiB, WS_PROJ = 96 * MiB, WS_G = 736 * MiB, WS_MG = 864 * MiB, WS_END = 928 * MiB;
static_assert(WS_XN + (size_t)MS * DM * 2 <= WS_PROJ && WS_PROJ + (size_t)MS * INC * 2 <= WS_G && WS_G + (size_t)MS * GW * 2 <= WS_MG && WS_MG + (size_t)MS * DM * 2 <= WS_END, "d_ws map");
static_assert(WS_LSE + (size_t)MS * NHA * 4 <= WS_XN, "lse map");
constexpr int LDS_BYTES = 147456;

#define LAS __attribute__((address_space(3)))
typedef unsigned short bf16;
typedef unsigned v4u __attribute__((ext_vector_type(4)));
typedef float f32x4 __attribute__((ext_vector_type(4)));
#define LDS_WAIT() asm volatile("s_waitcnt lgkmcnt(0)" ::: "memory")
__device__ __forceinline__ unsigned f2bf(float f) { unsigned u = __builtin_bit_cast(unsigned, f); return (u + 0x7fffu + ((u >> 16) & 1u)) >> 16; }
__device__ __forceinline__ unsigned pk2(float lo, float hi) { return f2bf(lo) | (f2bf(hi) << 16); }
__device__ __forceinline__ float bflo(unsigned u) { return __uint_as_float(u << 16); }
__device__ __forceinline__ float bfhi(unsigned u) { return __uint_as_float(u & 0xffff0000u); }
__device__ __forceinline__ float wave_sum(float v) {
#pragma unroll
    for (int o = 1; o < 64; o <<= 1) v += __shfl_xor(v, o);
    return v;
}

__device__ __forceinline__ void p0_transpose_item(const float* W, int K, int N, bf16* WT, int ldt, int koff, bool win, LAS float* scr, int item, int lane) {
    const int nblk = N / 32, kb = item / nblk, nb = item % nblk, k0 = 64 * kb, n0 = 32 * nb;
    const float sc = (win && ((n0 < C_KA) || (n0 >= C_QB && n0 < C_KB))) ? QSCALE : 1.0f;
#pragma unroll 8
    for (int i = 0; i < 32; ++i) { const int kk = 2 * i + (lane >> 5); scr[kk * 33 + (lane & 31)] = W[(size_t)(k0 + kk) * N + n0 + (lane & 31)] * sc; }
    LDS_WAIT(); asm volatile("" ::: "memory");
    const int c = lane & 7;
#pragma unroll
    for (int j = 0; j < 4; ++j) { const int n = (lane >> 3) + 8 * j; const LAS float* s = scr + (8 * c) * 33 + n;
        v4u o; o.x = pk2(s[0 * 33], s[1 * 33]); o.y = pk2(s[2 * 33], s[3 * 33]); o.z = pk2(s[4 * 33], s[5 * 33]); o.w = pk2(s[6 * 33], s[7 * 33]);
        *(v4u*)(WT + (size_t)(n0 + n) * ldt + koff + k0 + 8 * c) = o; }
    LDS_WAIT(); asm volatile("" ::: "memory");
}
__device__ __forceinline__ void rms_row_to_bf16(const float* xrow, const float* g, bf16* orow, int lane) {
    const f32x4* xr = (const f32x4*)xrow + lane; const f32x4* gr = (const f32x4*)g + lane;
    f32x4 v[4]; float s = 0.f;
#pragma unroll
    for (int j = 0; j < 4; ++j) { v[j] = xr[64 * j]; s += (v[j].x * v[j].x + v[j].y * v[j].y) + (v[j].z * v[j].z + v[j].w * v[j].w); }
    const float rstd = 1.f / sqrtf(wave_sum(s) * (1.f / DM) + RMS_EPS);
    unsigned long long* o8 = (unsigned long long*)orow + lane;
#pragma unroll
    for (int j = 0; j < 4; ++j) { const f32x4 gg = gr[64 * j];
        o8[64 * j] = (unsigned long long)pk2(v[j].x * rstd * gg.x, v[j].y * rstd * gg.y) | ((unsigned long long)pk2(v[j].z * rstd * gg.z, v[j].w * rstd * gg.w) << 32); }
}

__device__ __forceinline__ void ld_row64(const bf16* p, float (&f)[64]) {
#pragma unroll
    for (int c = 0; c < 8; ++c) { const v4u w = *(const v4u*)(p + 8 * c);
        f[8 * c + 0] = bflo(w.x); f[8 * c + 1] = bfhi(w.x); f[8 * c + 2] = bflo(w.y); f[8 * c + 3] = bfhi(w.y);
        f[8 * c + 4] = bflo(w.z); f[8 * c + 5] = bfhi(w.z); f[8 * c + 6] = bflo(w.w); f[8 * c + 7] = bfhi(w.w); }
}
__device__ __forceinline__ float dot_row64(const bf16* p, const float (&q)[64]) {
    float s0 = 0.f, s1 = 0.f;
#pragma unroll
    for (int c = 0; c < 8; ++c) { const v4u w = *(const v4u*)(p + 8 * c);
        s0 += q[8 * c + 0] * bflo(w.x); s1 += q[8 * c + 1] * bfhi(w.x); s0 += q[8 * c + 2] * bflo(w.y); s1 += q[8 * c + 3] * bfhi(w.y);
        s0 += q[8 * c + 4] * bflo(w.z); s1 += q[8 * c + 5] * bfhi(w.z); s0 += q[8 * c + 6] * bflo(w.w); s1 += q[8 * c + 7] * bfhi(w.w); }
    return s0 + s1;
}
__device__ __forceinline__ void axpy_row64(const bf16* p, float a, float (&o)[64]) {
#pragma unroll
    for (int c = 0; c < 8; ++c) { const v4u w = *(const v4u*)(p + 8 * c);
        o[8 * c + 0] += a * bflo(w.x); o[8 * c + 1] += a * bfhi(w.x); o[8 * c + 2] += a * bflo(w.y); o[8 * c + 3] += a * bfhi(w.y);
        o[8 * c + 4] += a * bflo(w.z); o[8 * c + 5] += a * bfhi(w.z); o[8 * c + 6] += a * bflo(w.w); o[8 * c + 7] += a * bfhi(w.w); }
}
__device__ __forceinline__ float siluf_(float x) { return x * __builtin_amdgcn_rcpf(1.0f + __builtin_amdgcn_exp2f(-x * LOG2E)); }

__device__ __forceinline__ void naive_attn_a(const bf16* P, bf16* G, float* LSE, long gtid, long nthr) {
    for (long idx = gtid; idx < (long)MS * NHA; idx += nthr) {
        const int hA = (int)(idx / MS), row = (int)(idx % MS), g = hA / 6, j = hA % 6;
        const int d = (g == 0) ? 1 : (g == 1 ? 4 : 16), L = SEQ / d;
        const int sb = row / SEQ, t = row % SEQ, mq = t / d, r = t % d;
        const float slope = exp2f(-8.0f * (float)(g + 3 * j + 1) / 18.0f) * LOG2E * (float)d;
        float q[64], o[64];
        ld_row64(P + (size_t)row * INC + C_QA + hA * 64, q);
#pragma unroll
        for (int e = 0; e < 64; ++e) o[e] = 0.f;
        float m = -1e30f, l = 0.f;
        const int lo = mq - 64 < 0 ? 0 : mq - 64, hi = mq + 64 > L - 1 ? L - 1 : mq + 64;
        for (int mk = lo; mk <= hi; ++mk) {
            const size_t krow = (size_t)(sb * SEQ + mk * d + r);
            const int off = mk > mq ? mk - mq : mq - mk;
            const float s = dot_row64(P + krow * INC + C_KA + hA * 64, q) - slope * (float)off;
            const float mn = fmaxf(m, s), cr = __builtin_amdgcn_exp2f(m - mn), p = __builtin_amdgcn_exp2f(s - mn);
            l = l * cr + p; m = mn;
#pragma unroll
            for (int e = 0; e < 64; ++e) o[e] *= cr;
            axpy_row64(P + krow * INC + C_VA + hA * 64, p, o);
        }
        const float rl = 1.0f / l;
        bf16* op = G + (size_t)row * GW + hA * 64;
#pragma unroll
        for (int c = 0; c < 8; ++c) { v4u w; w.x = pk2(o[8 * c] * rl, o[8 * c + 1] * rl); w.y = pk2(o[8 * c + 2] * rl, o[8 * c + 3] * rl); w.z = pk2(o[8 * c + 4] * rl, o[8 * c + 5] * rl); w.w = pk2(o[8 * c + 6] * rl, o[8 * c + 7] * rl); *(v4u*)(op + 8 * c) = w; }
        LSE[(size_t)row * NHA + hA] = m + log2f(l);
    }
}
__device__ __forceinline__ void naive_attn_b(const bf16* P, bf16* G, const float* rpb, long gtid, long nthr) {
    for (long idx = gtid; idx < (long)MS * NHB; idx += nthr) {
        const int h = (int)(idx / MS), row = (int)(idx % MS);
        const int sb = row / SEQ, t = row % SEQ, r = t / 64, c = t % 64;
        const int rs = r - 4 < 0 ? 0 : (r - 4 > 24 ? 24 : r - 4), cs = c - 8 < 0 ? 0 : (c - 8 > 48 ? 48 : c - 8);
        float q[64], o[64];
        ld_row64(P + (size_t)row * INC + C_QB + h * 64, q);
#pragma unroll
        for (int e = 0; e < 64; ++e) o[e] = 0.f;
        float m = -1e30f, l = 0.f;
        for (int kk = 0; kk < 128; ++kk) {
            const int kr = rs + (kk >> 4), kc = cs + (kk & 15);
            const size_t krow = (size_t)(sb * SEQ + kr * 64 + kc);
            const float bias = rpb[(h * 15 + (kr - r + 7)) * 31 + (kc - c + 15)] * LOG2E;
            const float s = dot_row64(P + krow * INC + C_KB + h * 64, q) + bias;
            const float mn = fmaxf(m, s), cr = __builtin_amdgcn_exp2f(m - mn), p = __builtin_amdgcn_exp2f(s - mn);
            l = l * cr + p; m = mn;
#pragma unroll
            for (int e = 0; e < 64; ++e) o[e] *= cr;
            axpy_row64(P + krow * INC + C_VB + h * 64, p, o);
        }
        const float rl = 1.0f / l;
        float z[64]; ld_row64(P + (size_t)row * INC + C_ZB + h * 64, z);
        bf16* op = G + (size_t)row * GW + WA + h * 64;
#pragma unroll
        for (int cc = 0; cc < 8; ++cc) { v4u w;
            w.x = pk2(o[8 * cc] * rl * siluf_(z[8 * cc]), o[8 * cc + 1] * rl * siluf_(z[8 * cc + 1])); w.y = pk2(o[8 * cc + 2] * rl * siluf_(z[8 * cc + 2]), o[8 * cc + 3] * rl * siluf_(z[8 * cc + 3]));
            w.z = pk2(o[8 * cc + 4] * rl * siluf_(z[8 * cc + 4]), o[8 * cc + 5] * rl * siluf_(z[8 * cc + 5])); w.w = pk2(o[8 * cc + 6] * rl * siluf_(z[8 * cc + 6]), o[8 * cc + 7] * rl * siluf_(z[8 * cc + 7]));
            *(v4u*)(op + 8 * cc) = w; }
    }
}
__device__ __forceinline__ void combine_a(const bf16* P, bf16* G, const float* LSE, long gtid, long nthr) {
    for (long idx = gtid; idx < (long)MS * NHA * 8; idx += nthr) {
        const int c8 = (int)(idx & 7), hA = (int)((idx >> 3) % NHA), row = (int)((idx >> 3) / NHA), j = hA % 6;
        const float l0 = LSE[(size_t)row * NHA + j], l1 = LSE[(size_t)row * NHA + 6 + j], l2 = LSE[(size_t)row * NHA + 12 + j], lm = fmaxf(l0, fmaxf(l1, l2));
        const float e0 = __builtin_amdgcn_exp2f(l0 - lm), e1 = __builtin_amdgcn_exp2f(l1 - lm), e2 = __builtin_amdgcn_exp2f(l2 - lm);
        const float mine = hA < 6 ? e0 : (hA < 12 ? e1 : e2), alpha = mine / (e0 + e1 + e2);
        bf16* gp = G + (size_t)row * GW + hA * 64 + c8 * 8; const v4u o = *(const v4u*)gp, z = *(const v4u*)(P + (size_t)row * INC + C_ZA + hA * 64 + c8 * 8);
        v4u w; w.x = pk2(bflo(o.x) * alpha * siluf_(bflo(z.x)), bfhi(o.x) * alpha * siluf_(bfhi(z.x))); w.y = pk2(bflo(o.y) * alpha * siluf_(bflo(z.y)), bfhi(o.y) * alpha * siluf_(bfhi(z.y)));
        w.z = pk2(bflo(o.z) * alpha * siluf_(bflo(z.z)), bfhi(o.z) * alpha * siluf_(bfhi(z.z))); w.w = pk2(bflo(o.w) * alpha * siluf_(bflo(z.w)), bfhi(o.w) * alpha * siluf_(bfhi(z.w)));
        *(v4u*)gp = w;
    }
}


typedef short bf16x8v __attribute__((ext_vector_type(8)));
typedef float f32x16 __attribute__((ext_vector_type(16)));
typedef short s16x4 __attribute__((ext_vector_type(4)));
constexpr int ATT_VSLOT = 0, ATT_RPB = 65536, ATT_LSE = ATT_RPB + 26112, ATT_ITEM = ATT_LSE + 6144;
constexpr int NA_UNITS = SLAB_SEQ * 6 * 4;
constexpr int NB_ITEMS = SLAB_SEQ * NHB * 8;
__device__ __forceinline__ s16x4 vtr(LAS const char* p) { return __builtin_bit_cast(s16x4, __builtin_amdgcn_ds_read_tr16_b64_v4i16((LAS s16x4*)p)); }
__device__ __forceinline__ unsigned cvtpk(float lo, float hi) { unsigned r; asm volatile("v_cvt_pk_bf16_f32 %0, %1, %2" : "=v"(r) : "v"(lo), "v"(hi)); return r; }
__device__ __forceinline__ int clampi(int v, int lo, int hi) { return v < lo ? lo : (v > hi ? hi : v); }

__device__ __forceinline__ f32x16 qk_tile(const bf16x8v (&kf)[4], const bf16x8v (&qf)[4]) {
    f32x16 sT;
#pragma unroll
    for (int e = 0; e < 16; ++e) sT[e] = 0.f;
#pragma unroll
    for (int s4 = 0; s4 < 4; ++s4) sT = __builtin_amdgcn_mfma_f32_32x32x16_bf16(kf[s4], qf[s4], sT, 0, 0, 0);
    return sT;
}
__device__ __forceinline__ void softmax_pv(f32x16& sT, f32x16 (&oT)[2], float& m, float& l, LAS const char* vtrb) {
    float tm = fmaxf(fmaxf(sT[0], sT[1]), fmaxf(sT[2], sT[3]));
#pragma unroll
    for (int e = 4; e < 16; e += 4) tm = fmaxf(tm, fmaxf(fmaxf(sT[e], sT[e + 1]), fmaxf(sT[e + 2], sT[e + 3])));
    tm = fmaxf(tm, __shfl_xor(tm, 32));
    const float mn = fmaxf(m, tm), cr = __builtin_amdgcn_exp2f(m - mn); m = mn;
    float ps = 0.f;
#pragma unroll
    for (int e = 0; e < 16; ++e) { sT[e] = __builtin_amdgcn_exp2f(sT[e] - mn); ps += sT[e]; }
    l = l * cr + ps;
#pragma unroll
    for (int e = 0; e < 16; ++e) { oT[0][e] *= cr; oT[1][e] *= cr; }
    bf16x8v pf[2];
#pragma unroll
    for (int s2 = 0; s2 < 2; ++s2) { v4u w; w.x = cvtpk(sT[8 * s2 + 0], sT[8 * s2 + 1]); w.y = cvtpk(sT[8 * s2 + 2], sT[8 * s2 + 3]); w.z = cvtpk(sT[8 * s2 + 4], sT[8 * s2 + 5]); w.w = cvtpk(sT[8 * s2 + 6], sT[8 * s2 + 7]); pf[s2] = __builtin_bit_cast(bf16x8v, w); }
#pragma unroll
    for (int dt = 0; dt < 2; ++dt)
#pragma unroll
        for (int s2 = 0; s2 < 2; ++s2) { const s16x4 lo = vtr(vtrb + dt * 2048 + s2 * 1024), hi = vtr(vtrb + dt * 2048 + s2 * 1024 + 512);
            const bf16x8v vf = (bf16x8v){lo[0], lo[1], lo[2], lo[3], hi[0], hi[1], hi[2], hi[3]};
            oT[dt] = __builtin_amdgcn_mfma_f32_32x32x16_bf16(vf, pf[s2], oT[dt], 0, 0, 0); }
}
#define ATT_VWRITE(slot, vc) do { _Pragma("unroll") for (int i_ = 0; i_ < 4; ++i_) { const int idx_ = i_ * 64 + lane, key_ = idx_ >> 3, cc_ = idx_ & 7; \
        *(LAS v4u*)((slot) + (cc_ >> 2) * 2048 + key_ * 64 + (cc_ & 3) * 16) = vc[i_]; } } while (0)

__device__ __forceinline__ void attn_a_wave_unit(const bf16* P, bf16* G, LAS float* lseT, LAS char* vslots, int sb, int j, int c, int wu, int lane) {
    const int g = wu >> 4, u = wu & 15, dsh = 2 * g, d = 1 << dsh, Lq = SEQ >> dsh;
    const int r = u & (d - 1), n = u >> dsh, m0 = (512 >> dsh) * c + 32 * n, hA = g * 6 + j;
    const float slope_d = __builtin_amdgcn_exp2f(-8.0f * (float)(g + 3 * j + 1) / 18.0f) * LOG2E * (float)d;
    const int r32 = lane & 31, hi = lane >> 5;
    const size_t seqrow = (size_t)sb * SEQ;
    const int tq = (m0 + r32) * d + r;
    const bf16* qp = P + (seqrow + tq) * INC + C_QA + hA * 64 + 8 * hi;
    bf16x8v qf[4];
#pragma unroll
    for (int s4 = 0; s4 < 4; ++s4) qf[s4] = *(const bf16x8v*)(qp + 16 * s4);
    const bf16* kbase = P + seqrow * INC + C_KA + hA * 64 + 8 * hi; const bf16* vbase = P + seqrow * INC + C_VA + hA * 64;
    f32x16 oT[2];
#pragma unroll
    for (int e = 0; e < 16; ++e) { oT[0][e] = 0.f; oT[1][e] = 0.f; }
    float m = -1e30f, l = 0.f;
    bf16x8v kfn[4]; v4u vcn[4];
#define A_ISSUE(kt) do { const int mk_ = clampi(m0 - 64 + 32 * (kt) + r32, 0, Lq - 1); const bf16* kp_ = kbase + (size_t)(mk_ * d + r) * INC; \
        _Pragma("unroll") for (int s4 = 0; s4 < 4; ++s4) kfn[s4] = *(const bf16x8v*)(kp_ + 16 * s4); \
        _Pragma("unroll") for (int i_ = 0; i_ < 4; ++i_) { const int idx_ = i_ * 64 + lane, key_ = idx_ >> 3, cc_ = idx_ & 7; const int mv_ = clampi(m0 - 64 + 32 * (kt) + key_, 0, Lq - 1); \
            vcn[i_] = *(const v4u*)(vbase + (size_t)(mv_ * d + r) * INC + cc_ * 8); } } while (0)
    A_ISSUE(0);
    LAS const char* vtr0 = vslots + ((lane >> 4) & 1) * 32 + (lane & 3) * 8 + (4 * hi + ((lane & 15) >> 2)) * 64;
    for (int kt = 0; kt < 5; ++kt) {
        bf16x8v kf[4]; v4u vc[4];
#pragma unroll
        for (int s4 = 0; s4 < 4; ++s4) { kf[s4] = kfn[s4]; vc[s4] = vcn[s4]; }
        if (kt < 4) A_ISSUE(kt + 1);
        LAS char* slot = vslots + (kt & 1) * 4096;
        ATT_VWRITE(slot, vc);
        f32x16 sT = qk_tile(kf, qf);
        const int ob = 32 * kt - 64 - r32 + 4 * hi, mb = m0 - 64 + 32 * kt + 4 * hi;
#pragma unroll
        for (int e = 0; e < 16; ++e) { const int ko = (e & 3) + 8 * (e >> 2), off = ob + ko, mk = mb + ko, ao = off < 0 ? -off : off;
            const bool valid = (ao <= 64) && (mk >= 0) && (mk < Lq);
            sT[e] = valid ? sT[e] - slope_d * (float)ao : -1e30f; }
        softmax_pv(sT, oT, m, l, vtr0 + (kt & 1) * 4096);
    }
#undef A_ISSUE
    const float lt = l + __shfl_xor(l, 32), inv = 1.0f / lt;
    bf16* op = G + (seqrow + tq) * GW + hA * 64 + 4 * hi;
#pragma unroll
    for (int dt = 0; dt < 2; ++dt)
#pragma unroll
        for (int g4 = 0; g4 < 4; ++g4) { unsigned long long w = (unsigned long long)cvtpk(oT[dt][4 * g4] * inv, oT[dt][4 * g4 + 1] * inv) | ((unsigned long long)cvtpk(oT[dt][4 * g4 + 2] * inv, oT[dt][4 * g4 + 3] * inv) << 32);
            *(unsigned long long*)(op + 32 * dt + 8 * g4) = w; }
    if (hi == 0) lseT[(tq - 512 * c) * 3 + g] = m + __builtin_amdgcn_logf(lt);
}
__device__ __forceinline__ void attn_b_wave_unit(const bf16* P, bf16* G, LAS const float* rpbL, LAS char* vslots, int sb, int h, int rp, int cb, int lane) {
    const int r32 = lane & 31, hi = lane >> 5;
    const int r0 = 2 * rp, qr = r0 + (r32 >> 4), qc = 16 * cb + (r32 & 15);
    const int rs_q = clampi(qr - 4, 0, 24), cs_q = clampi(qc - 8, 0, 48);
    const int rsA = clampi(r0 - 4, 0, 24), rsB = clampi(r0 - 3, 0, 24), nk = rsB - rsA + 8, s0 = clampi(16 * cb - 8, 0, 32);
    const size_t seqrow = (size_t)sb * SEQ;
    const int tq = qr * 64 + qc;
    const bf16* qp = P + (seqrow + tq) * INC + C_QB + h * 64 + 8 * hi;
    bf16x8v qf[4];
#pragma unroll
    for (int s4 = 0; s4 < 4; ++s4) qf[s4] = *(const bf16x8v*)(qp + 16 * s4);
    const bf16* kbase = P + (seqrow + s0) * INC + C_KB + h * 64 + 8 * hi; const bf16* vbase = P + (seqrow + s0) * INC + C_VB + h * 64;
    f32x16 oT[2];
#pragma unroll
    for (int e = 0; e < 16; ++e) { oT[0][e] = 0.f; oT[1][e] = 0.f; }
    float m = -1e30f, l = 0.f;
    bf16x8v kfn[4]; v4u vcn[4];
#define B_ISSUE(kt) do { const bf16* kp_ = kbase + (size_t)((rsA + (kt)) * 64 + r32) * INC; \
        _Pragma("unroll") for (int s4 = 0; s4 < 4; ++s4) kfn[s4] = *(const bf16x8v*)(kp_ + 16 * s4); \
        _Pragma("unroll") for (int i_ = 0; i_ < 4; ++i_) { const int idx_ = i_ * 64 + lane, key_ = idx_ >> 3, cc_ = idx_ & 7; \
            vcn[i_] = *(const v4u*)(vbase + (size_t)((rsA + (kt)) * 64 + key_) * INC + cc_ * 8); } } while (0)
    B_ISSUE(0);
    LAS const char* vtr0 = vslots + ((lane >> 4) & 1) * 32 + (lane & 3) * 8 + (4 * hi + ((lane & 15) >> 2)) * 64;
    for (int kt = 0; kt < nk; ++kt) {
        bf16x8v kf[4]; v4u vc[4];
#pragma unroll
        for (int s4 = 0; s4 < 4; ++s4) { kf[s4] = kfn[s4]; vc[s4] = vcn[s4]; }
        if (kt + 1 < nk) B_ISSUE(kt + 1);
        LAS char* slot = vslots + (kt & 1) * 4096;
        ATT_VWRITE(slot, vc);
        f32x16 sT = qk_tile(kf, qf);
        const int kr = rsA + kt; const bool rowv = (kr >= rs_q) && (kr < rs_q + 8);
        LAS const float* brow = rpbL + (h * 15 + (kr - qr + 7)) * 31;
#pragma unroll
        for (int e = 0; e < 16; ++e) { const int kc = s0 + 4 * hi + (e & 3) + 8 * (e >> 2);
            const bool valid = rowv && (kc >= cs_q) && (kc < cs_q + 16);
            const float bias = brow[clampi(kc - qc, -15, 15) + 15];
            sT[e] = valid ? sT[e] + bias : -1e30f; }
        softmax_pv(sT, oT, m, l, vtr0 + (kt & 1) * 4096);
    }
#undef B_ISSUE
    const float lt = l + __shfl_xor(l, 32), inv = 1.0f / lt;
    const bf16* zp = P + (seqrow + tq) * INC + C_ZB + h * 64 + 4 * hi;
    bf16* op = G + (seqrow + tq) * GW + WA + h * 64 + 4 * hi;
#pragma unroll
    for (int dt = 0; dt < 2; ++dt)
#pragma unroll
        for (int g4 = 0; g4 < 4; ++g4) { const unsigned long long z = *(const unsigned long long*)(zp + 32 * dt + 8 * g4); const unsigned zl = (unsigned)z, zh = (unsigned)(z >> 32);
            unsigned long long w = (unsigned long long)cvtpk(oT[dt][4 * g4] * inv * siluf_(bflo(zl)), oT[dt][4 * g4 + 1] * inv * siluf_(bfhi(zl))) |
                                   ((unsigned long long)cvtpk(oT[dt][4 * g4 + 2] * inv * siluf_(bflo(zh)), oT[dt][4 * g4 + 3] * inv * siluf_(bfhi(zh))) << 32);
            *(unsigned long long*)(op + 32 * dt + 8 * g4) = w; }
}
__device__ __forceinline__ void mixer_phase(LAS unsigned char* L, const bf16* P, bf16* G, const float* rpb, unsigned* ctr, int tid) {
    const int lane = tid & 63, wave = __builtin_amdgcn_readfirstlane(tid >> 6);
    LAS float* rpbL = (LAS float*)(L + ATT_RPB); LAS float* lseT = (LAS float*)(L + ATT_LSE); volatile LAS int* itemw = (volatile LAS int*)(L + ATT_ITEM);
    LAS char* vslots = (LAS char*)(L + ATT_VSLOT + wave * 8192);
    for (int i = tid; i < NHB * 15 * 31; i += NTHR) rpbL[i] = rpb[i] * LOG2E;
    for (;;) {
        __syncthreads();
        if (tid == 0) *itemw = (int)atomicAdd(ctr, 1u);
        __syncthreads();
        const int item = __builtin_amdgcn_readfirstlane(*itemw);
        if (item >= NA_UNITS + NB_ITEMS) break;
        if (item < NA_UNITS) {
            const int sb = item / 24, j = (item / 4) % 6, c = item & 3;
            for (int i = 0; i < 6; ++i) attn_a_wave_unit(P, G, lseT, vslots, sb, j, c, wave + 8 * i, lane);
            __syncthreads();
            const size_t row0 = (size_t)sb * SEQ + 512 * c;
            for (int e = tid; e < 512 * 24; e += NTHR) {
                const int tok = e / 24, rem = e - tok * 24, g = rem >> 3, c8 = rem & 7, hA = g * 6 + j;
                const float l0 = lseT[tok * 3], l1 = lseT[tok * 3 + 1], l2 = lseT[tok * 3 + 2], lm = fmaxf(l0, fmaxf(l1, l2));
                const float e0 = __builtin_amdgcn_exp2f(l0 - lm), e1 = __builtin_amdgcn_exp2f(l1 - lm), e2 = __builtin_amdgcn_exp2f(l2 - lm);
                const float alpha = (g == 0 ? e0 : (g == 1 ? e1 : e2)) / (e0 + e1 + e2);
                bf16* gp = G + (row0 + tok) * GW + hA * 64 + c8 * 8; const v4u o = *(const v4u*)gp, z = *(const v4u*)(P + (row0 + tok) * INC + C_ZA + hA * 64 + c8 * 8);
                v4u w; w.x = pk2(bflo(o.x) * alpha * siluf_(bflo(z.x)), bfhi(o.x) * alpha * siluf_(bfhi(z.x))); w.y = pk2(bflo(o.y) * alpha * siluf_(bflo(z.y)), bfhi(o.y) * alpha * siluf_(bfhi(z.y)));
                w.z = pk2(bflo(o.z) * alpha * siluf_(bflo(z.z)), bfhi(o.z) * alpha * siluf_(bfhi(z.z))); w.w = pk2(bflo(o.w) * alpha * siluf_(bflo(z.w)), bfhi(o.w) * alpha * siluf_(bfhi(z.w)));
                *(v4u*)gp = w;
            }
        } else {
            const int it = item - NA_UNITS, sb = it / (NHB * 8), h = (it >> 3) % NHB, pr = it & 7;
            attn_b_wave_unit(P, G, rpbL, vslots, sb, h, 2 * pr + (wave >> 2), wave & 3, lane);
        }
    }
}

struct Args { const float* in[10]; float* out; unsigned char* ws; };
__global__ void __launch_bounds__(NTHR, 2) fwd_megakernel(Args args) {
    extern __shared__ __attribute__((aligned(16))) unsigned char lds[];
    cg::grid_group grid = cg::this_grid();
    LAS unsigned char* L = (LAS unsigned char*)lds;
    const int G = gridDim.x, bx = blockIdx.x;
    const int NGW = G * NWAVES; const long nthr = (long)G * NTHR;
#define PHASE_IDS() int tid = threadIdx.x; asm volatile("" : "+v"(tid)); const int lane = tid & 63, wave = __builtin_amdgcn_readfirstlane(tid >> 6), gw = bx * NWAVES + wave; const long gtid = (long)bx * NTHR + tid; (void)lane; (void)gw; (void)gtid
    unsigned char* ws = args.ws;
    const float *xp = args.in[0], *xs = args.in[1], *norm_pre = args.in[2], *w_in = args.in[3], *b_gate = args.in[4], *rpb = args.in[5], *w_pa = args.in[6], *w_pb = args.in[7], *w_out = args.in[8], *norm_post = args.in[9];
    bf16* WIN = (bf16*)(ws + WS_WIN); bf16* WAB = (bf16*)(ws + WS_WAB); bf16* WOUT = (bf16*)(ws + WS_WOUT);
    float* SS = (float*)(ws + WS_SS); float* LSE = (float*)(ws + WS_LSE); unsigned* CTR = (unsigned*)(ws + WS_CTL);
    bf16* XN = (bf16*)(ws + WS_XN); bf16* PROJ = (bf16*)(ws + WS_PROJ); bf16* GB_ = (bf16*)(ws + WS_G); bf16* MG = (bf16*)(ws + WS_MG);

    {
        PHASE_IDS();
        LAS float* scr = (LAS float*)(L + wave * 16384);
        constexpr int I_IN = (DM / 64) * (INC / 32), I_A = (WA / 64) * (DM / 32), I_B = (WB / 64) * (DM / 32), I_O = (DM / 64) * (DM / 32);
        for (int it = gw; it < I_IN + I_A + I_B + I_O; it += NGW) {
            int r = it;
            if (r < I_IN) { p0_transpose_item(w_in, DM, INC, WIN, DM, 0, true, scr, r, lane); continue; } r -= I_IN;
            if (r < I_A) { p0_transpose_item(w_pa, WA, DM, WAB, GW, 0, false, scr, r, lane); continue; } r -= I_A;
            if (r < I_B) { p0_transpose_item(w_pb, WB, DM, WAB, GW, WA, false, scr, r, lane); continue; } r -= I_B;
            p0_transpose_item(w_out, DM, DM, WOUT, DM, 0, false, scr, r, lane);
        }
        for (long i = gtid; i < MTOT; i += nthr) SS[i] = 0.f;
        if (gtid < 64) CTR[gtid] = 0u;
    }
    for (int s = 0; s < NSLAB; ++s) {
        const float* xsl = (s == 0) ? xp : xs + (size_t)(s - 1) * MS * DM;
        float* osl = args.out + (size_t)s * MS * DM;
        float* sssl = SS + (size_t)s * MS;
        const bf16 *XNp = XN, *WINp = WIN, *WABp = WAB, *WOUTp = WOUT, *MGp = MG; bf16* Gp = GB_;
        asm volatile("" : "+s"(XNp), "+s"(WINp), "+s"(WABp), "+s"(WOUTp), "+s"(MGp), "+s"(Gp));
        { PHASE_IDS(); for (int m = gw; m < MS; m += NGW) rms_row_to_bf16(xsl + (size_t)m * DM, norm_pre, XN + (size_t)m * DM, lane); }
        grid.sync();
        { pg8::Gemm g{XNp, WINp, MS, INC, DM}; pg8::StaticOrder S; S.init(MS, INC, G, bx); pg8::EpiProj E{PROJ, b_gate};
          pg8::gemm_phase<pg8::EpiProj, pg8::StaticOrder>(L, g, S, E); }
        grid.sync();
#ifdef NAIVE_MIXERS
        { PHASE_IDS(); naive_attn_a(PROJ, GB_, LSE, gtid, nthr); }
        { PHASE_IDS(); naive_attn_b(PROJ, GB_, rpb, gtid, nthr); }
        grid.sync();
        { PHASE_IDS(); combine_a(PROJ, GB_, LSE, gtid, nthr); }
#else
        { PHASE_IDS(); mixer_phase(L, PROJ, GB_, rpb, CTR + s, tid); }
#endif
        grid.sync();
        { pg8::Gemm g{Gp, WABp, MS, DM, GW}; pg8::StaticOrder S; S.init(MS, DM, G, bx); pg8::EpiGate E{PROJ, MG};
          pg8::gemm_phase<pg8::EpiGate, pg8::StaticOrder>(L, g, S, E); }
        grid.sync();
        { pg8::Gemm g{MGp, WOUTp, MS, DM, DM}; pg8::StaticOrder S; S.init(MS, DM, G, bx); pg8::EpiOut E{osl, sssl};
          pg8::gemm_phase<pg8::EpiOut, pg8::StaticOrder>(L, g, S, E); }
        grid.sync();
        { PHASE_IDS();
        for (int m = gw; m < MS; m += NGW) {
            const float rstd = 1.f / sqrtf(sssl[m] * (1.f / DM) + RMS_EPS);
            const f32x4* xr = (const f32x4*)(xsl + (size_t)m * DM) + lane; f32x4* tr = (f32x4*)(osl + (size_t)m * DM) + lane; const f32x4* gr = (const f32x4*)norm_post + lane;
#pragma unroll
            for (int j = 0; j < 4; ++j) { const f32x4 t = tr[64 * j], x = xr[64 * j], gg = gr[64 * j]; tr[64 * j] = x + t * rstd * gg; }
        } }
    }
}

extern "C" void kernel_launch(void* const* d_in, const int* in_sizes, int n_in, void* d_out, int out_size, void* d_ws, size_t ws_size, hipStream_t stream) {
    static int grid = 0;
    if (grid == 0) {
        if (n_in != 10 || out_size != MTOT * DM || ws_size < WS_END) { fprintf(stderr, "kernel_launch: bad shapes: n_in %d out %d ws %zu (need %zu)\n", n_in, out_size, ws_size, (size_t)WS_END); grid = -1; return; }
        int dev = 0, cus = 0, per_cu = 0;
        hipGetDevice(&dev); hipDeviceGetAttribute(&cus, hipDeviceAttributeMultiprocessorCount, dev);
        if (hipFuncSetAttribute((const void*)fwd_megakernel, hipFuncAttributeMaxDynamicSharedMemorySize, LDS_BYTES) != hipSuccess) { fprintf(stderr, "kernel_launch: hipFuncSetAttribute failed\n"); grid = -1; return; }
        hipOccupancyMaxActiveBlocksPerMultiprocessor(&per_cu, (const void*)fwd_megakernel, NTHR, LDS_BYTES);
        if (per_cu < 1) { fprintf(stderr, "kernel_launch: occupancy query says %d blocks per CU\n", per_cu); per_cu = 1; }
        (void)hipGetLastError();
        grid = cus;
    }
    if (grid < 0) return;
    Args a{};
    for (int i = 0; i < 10; ++i) a.in[i] = (const float*)d_in[i];
    a.out = (float*)d_out; a.ws = (unsigned char*)d_ws;
    void* kargs[] = {&a};
    hipError_t e = hipLaunchCooperativeKernel((const void*)fwd_megakernel, dim3(grid), dim3(NTHR), kargs, LDS_BYTES, stream);
    if (e != hipSuccess) fprintf(stderr, "cooperative launch failed: %s (grid %d)\n", hipGetErrorString(e), grid);
}
```

```cpp
#include <hip/hip_runtime.h>
#include <hip/hip_cooperative_groups.h>
#include <cstdio>
#include <cstdint>
namespace cg = cooperative_groups;

constexpr int DM = 1024, SEQ = 2048, NSEQ = 48, MTOT = NSEQ * SEQ;
constexpr int SLAB_SEQ = 16, MS = SLAB_SEQ * SEQ, NSLAB = NSEQ / SLAB_SEQ;
constexpr int WA = 1152, WB = 896, INC = 10240, GW = WA + WB;
constexpr int C_QA = 0, C_KA = 1152, C_VA = 2304, C_ZA = 3456, C_QB = 4608, C_KB = 5504, C_VB = 6400, C_ZB = 7296, C_GA = 8192, C_GB = 9216;
constexpr int NHA = 18, NHB = 14;
constexpr float LOG2E = 1.4426950408889634f;
constexpr float QSCALE = 0.125f * LOG2E;
constexpr float RMS_EPS = 1e-6f;

namespace pg8 {
#define PG8_LAS __attribute__((address_space(3)))
typedef unsigned short bf16_t;
typedef short bf16x8 __attribute__((ext_vector_type(8)));
typedef float f32x4 __attribute__((ext_vector_type(4)));
typedef unsigned u32x4 __attribute__((ext_vector_type(4)));
constexpr int BM = 256, BK = 64, HALF = 128, HTB = HALF * BK * 2, STAGE_BYTES = 8 * HTB, NXCD = 8, WGM = 8;

__host__ __device__ __forceinline__ int lds_byte(int r, int c) { const int st = (r >> 4) * 2 + (c >> 5), rr = r & 15, cc = c & 31, ob = rr * 64 + cc * 2; return st * 1024 + (ob ^ (((ob >> 9) & 1) << 5)); }
__host__ __device__ __forceinline__ void stage_rc(int b, int& R, int& C) { const int st = b / 1024, sb = b % 1024, swz = sb ^ (((sb >> 9) & 1) << 5); R = (st >> 1) * 16 + swz / 64; C = (st & 1) * 32 + (swz % 64) / 2; }
__host__ __device__ __forceinline__ int perm32(int rho) { const int n = rho >> 4, i = rho & 15; return 8 * (i >> 2) + 4 * n + (i & 3); }

struct Unit { int pm, pn; };
struct Gemm { const bf16_t* A; const bf16_t* Bt; int M, N, K; };

struct StaticOrder {
    int nM, nN, nwg, G, c;
    __host__ __device__ void init(int M, int N, int G_, int c_) { nM = M / BM; nN = N / BM; nwg = nM * nN; G = G_; c = c_; }
    __host__ __device__ bool next(int i, Unit& u) const {
        const long L = (long)i * G + c; if (L >= nwg) return false;
        int wgid = (int)L; { const int q = nwg / NXCD, r = nwg % NXCD, xcd = wgid % NXCD, off = wgid / NXCD; wgid = (xcd < r ? xcd * (q + 1) : r * (q + 1) + (xcd - r) * q) + off; }
        const int nig = WGM * nN, gid = wgid / nig, fm = gid * WGM, gsz = (nM - fm) < WGM ? (nM - fm) : WGM;
        u.pm = fm + ((wgid % nig) % gsz); u.pn = (wgid % nig) / gsz; return true;
    }
};

__device__ __forceinline__ unsigned cvt_pk_bf16(float lo, float hi) { unsigned r; asm volatile("v_cvt_pk_bf16_f32 %0, %1, %2" : "=v"(r) : "v"(lo), "v"(hi)); return r; }
__device__ __forceinline__ float bf_lo(unsigned u) { return __uint_as_float(u << 16); }
__device__ __forceinline__ float bf_hi(unsigned u) { return __uint_as_float(u & 0xffff0000u); }
__device__ __forceinline__ float sigmoidf_(float x) { return __builtin_amdgcn_rcpf(1.0f + __builtin_amdgcn_exp2f(-x * LOG2E)); }

struct EpiProj {
    static constexpr bool PERM = true, HOOK = false; static constexpr int HOOK_T = -1;
    bf16_t* O; const float* bgate;
    __device__ __forceinline__ void mid(f32x4 (&acc)[2][2][4][2], const Unit& u, int wr, int wc, int fr, int fq) const {}
    __device__ __forceinline__ void operator()(const f32x4 (&acc)[2][2][4][2], const Unit& u, int wr, int wc, int fr, int fq) const {
        const int row0 = u.pm * BM + wr * 64 + fr; const int col0 = u.pn * BM + wc * 32 + 8 * fq;
        const bool gate = u.pn >= 32;
        f32x4 bv[2][2];
#pragma unroll
        for (int bj = 0; bj < 2; ++bj)
#pragma unroll
            for (int n = 0; n < 2; ++n) bv[bj][n] = gate ? *(const f32x4*)(bgate + (col0 - C_GA) + bj * HALF + 4 * n) : (f32x4){0.f, 0.f, 0.f, 0.f};
#pragma unroll
        for (int ai = 0; ai < 2; ++ai)
#pragma unroll
            for (int m = 0; m < 4; ++m) { bf16_t* rowp = O + (size_t)(row0 + ai * HALF + m * 16) * INC + col0;
#pragma unroll
                for (int bj = 0; bj < 2; ++bj) { f32x4 v0 = acc[ai][bj][m][0], v1 = acc[ai][bj][m][1];
                    if (gate) { v0 = v0 + bv[bj][0]; v1 = v1 + bv[bj][1];
#pragma unroll
                        for (int e = 0; e < 4; ++e) { v0[e] = sigmoidf_(v0[e]); v1[e] = sigmoidf_(v1[e]); } }
                    u32x4 w; w.x = cvt_pk_bf16(v0[0], v0[1]); w.y = cvt_pk_bf16(v0[2], v0[3]); w.z = cvt_pk_bf16(v1[0], v1[1]); w.w = cvt_pk_bf16(v1[2], v1[3]);
                    *(u32x4*)(rowp + bj * HALF) = w; } }
    }
};
struct EpiGate {
    static constexpr bool PERM = true, HOOK = true; static constexpr int HOOK_T = WA / BK;
    const bf16_t* P; bf16_t* O;
    __device__ __forceinline__ void mid(f32x4 (&acc)[2][2][4][2], const Unit& u, int wr, int wc, int fr, int fq) const {
        int z = 0; asm volatile("" : "+v"(z));
        const unsigned off0 = (unsigned)(((u.pm * BM + wr * 64 + fr + z) * INC + u.pn * BM + wc * 32 + 8 * fq) * 2);
        const char* pb = (const char*)P;
#pragma unroll
        for (int ai = 0; ai < 2; ++ai)
#pragma unroll
            for (int m = 0; m < 4; ++m) { const unsigned off = off0 + (unsigned)((ai * HALF + m * 16) * INC * 2);
#pragma unroll
                for (int bj = 0; bj < 2; ++bj) {
                    const u32x4 a = *(const u32x4*)(pb + off + (C_GA + bj * HALF) * 2), b = *(const u32x4*)(pb + off + (C_GB + bj * HALF) * 2);
                    f32x4 r0, r1;
                    r0[0] = bf_lo(a.x) * __builtin_amdgcn_rcpf(bf_lo(b.x)); r0[1] = bf_hi(a.x) * __builtin_amdgcn_rcpf(bf_hi(b.x));
                    r0[2] = bf_lo(a.y) * __builtin_amdgcn_rcpf(bf_lo(b.y)); r0[3] = bf_hi(a.y) * __builtin_amdgcn_rcpf(bf_hi(b.y));
                    r1[0] = bf_lo(a.z) * __builtin_amdgcn_rcpf(bf_lo(b.z)); r1[1] = bf_hi(a.z) * __builtin_amdgcn_rcpf(bf_hi(b.z));
                    r1[2] = bf_lo(a.w) * __builtin_amdgcn_rcpf(bf_lo(b.w)); r1[3] = bf_hi(a.w) * __builtin_amdgcn_rcpf(bf_hi(b.w));
                    acc[ai][bj][m][0] = acc[ai][bj][m][0] * r0; acc[ai][bj][m][1] = acc[ai][bj][m][1] * r1; }
                asm volatile("" ::: "memory"); }
    }
    __device__ __forceinline__ void operator()(const f32x4 (&acc)[2][2][4][2], const Unit& u, int wr, int wc, int fr, int fq) const {
        const int row0 = u.pm * BM + wr * 64 + fr; const int col0 = u.pn * BM + wc * 32 + 8 * fq;
#pragma unroll
        for (int ai = 0; ai < 2; ++ai)
#pragma unroll
            for (int m = 0; m < 4; ++m) { const size_t row = (size_t)(row0 + ai * HALF + m * 16); const bf16_t* gp = P + row * INC + C_GB + col0; bf16_t* op = O + row * DM + col0;
#pragma unroll
                for (int bj = 0; bj < 2; ++bj) { const u32x4 b = *(const u32x4*)(gp + bj * HALF);
                    const f32x4 v0 = acc[ai][bj][m][0], v1 = acc[ai][bj][m][1];
                    u32x4 w; w.x = cvt_pk_bf16(v0[0] * bf_lo(b.x), v0[1] * bf_hi(b.x)); w.y = cvt_pk_bf16(v0[2] * bf_lo(b.y), v0[3] * bf_hi(b.y));
                    w.z = cvt_pk_bf16(v1[0] * bf_lo(b.z), v1[1] * bf_hi(b.z)); w.w = cvt_pk_bf16(v1[2] * bf_lo(b.w), v1[3] * bf_hi(b.w));
                    *(u32x4*)(op + bj * HALF) = w; } }
    }
};
struct EpiOut {
    static constexpr bool PERM = true, HOOK = false; static constexpr int HOOK_T = -1;
    float* T; float* ss;
    __device__ __forceinline__ void mid(f32x4 (&acc)[2][2][4][2], const Unit& u, int wr, int wc, int fr, int fq) const {}
    __device__ __forceinline__ void operator()(const f32x4 (&acc)[2][2][4][2], const Unit& u, int wr, int wc, int fr, int fq) const {
        const int row0 = u.pm * BM + wr * 64 + fr; const int col0 = u.pn * BM + wc * 32 + 8 * fq;
#pragma unroll
        for (int ai = 0; ai < 2; ++ai)
#pragma unroll
            for (int m = 0; m < 4; ++m) { const size_t row = (size_t)(row0 + ai * HALF + m * 16); float* op = T + row * DM + col0; float s = 0.f;
#pragma unroll
                for (int bj = 0; bj < 2; ++bj) { const f32x4 v0 = acc[ai][bj][m][0], v1 = acc[ai][bj][m][1];
                    s += (v0[0] * v0[0] + v0[1] * v0[1]) + (v0[2] * v0[2] + v0[3] * v0[3]) + (v1[0] * v1[0] + v1[1] * v1[1]) + (v1[2] * v1[2] + v1[3] * v1[3]);
                    *(f32x4*)(op + bj * HALF) = v0; *(f32x4*)(op + bj * HALF + 4) = v1; }
                s += __shfl_xor(s, 16); s += __shfl_xor(s, 32);
                if (fq == 0) atomicAdd(ss + row, s); }
    }
};

template <class Epi, class Sched, bool ALIGN_EPI = true>
__device__ __forceinline__ void gemm_phase(PG8_LAS unsigned char* lds, const Gemm g, const Sched& S, const Epi& E) {
    int tid = threadIdx.x; asm volatile("" : "+v"(tid));
    const int wid = __builtin_amdgcn_readfirstlane(tid >> 6), lane = tid & 63, wr = wid >> 2, wc = wid & 3, fr = lane & 15, fq = lane >> 4;
    const int K = g.K, nt = K / BK;
    unsigned voffA[2], voffB[2];
#pragma unroll
    for (int i = 0; i < 2; ++i) { int R, C; stage_rc(tid * 16 + i * 8192, R, C); const int Rb = Epi::PERM ? ((R & ~31) + perm32(R & 31)) : R;
        voffA[i] = (unsigned)(R * K + C) * 2u; voffB[i] = (unsigned)(Rb * K + C) * 2u; }
    const size_t kstep = (size_t)(BK * 2);
    const size_t hstep = (size_t)HALF * K * 2;
    const size_t tstep = 2 * hstep;
    const unsigned ldsw = (unsigned)wid * 1024u;
    const int aoff = lds_byte(wr * 64 + fr, fq * 8), boff = lds_byte(wc * 32 + fr, fq * 8);
#define PG8_SA(b, h) (((b) * 2 + (h)) * HTB)
#define PG8_SB(b, h) ((4 + (b) * 2 + (h)) * HTB)
#define PG8_STAGE(bufoff, gbase, voff) do { _Pragma("unroll") for (int _i = 0; _i < 2; ++_i) \
        __builtin_amdgcn_global_load_lds((const unsigned*)((const char*)(gbase) + (voff)[_i]), (PG8_LAS unsigned*)(lds + (bufoff) + ldsw + _i * 8192), 16, 0, 0); } while (0)
#define PG8_LDA(dst, b, h) do { _Pragma("unroll") for (int m = 0; m < 4; ++m) _Pragma("unroll") for (int k = 0; k < 2; ++k) dst[m][k] = *(const PG8_LAS bf16x8*)(lds + PG8_SA(b, h) + aoff + m * 2048 + k * 1024); } while (0)
#define PG8_LDB(dst, b, h) do { _Pragma("unroll") for (int n = 0; n < 2; ++n) _Pragma("unroll") for (int k = 0; k < 2; ++k) dst[n][k] = *(const PG8_LAS bf16x8*)(lds + PG8_SB(b, h) + boff + n * 2048 + k * 1024); } while (0)
#define PG8_MMA(ai, bj, At, Bt) do { __builtin_amdgcn_s_setprio(1); _Pragma("unroll") for (int m = 0; m < 4; ++m) _Pragma("unroll") for (int n = 0; n < 2; ++n) _Pragma("unroll") for (int k = 0; k < 2; ++k) \
        acc[ai][bj][m][n] = __builtin_amdgcn_mfma_f32_16x16x32_bf16(Bt[n][k], At[m][k], acc[ai][bj][m][n], 0, 0, 0); __builtin_amdgcn_s_setprio(0); } while (0)
#define PG8_WAIT_V(n) asm volatile("s_waitcnt vmcnt(" #n ")" ::: "memory")
#define PG8_WAIT_L(n) asm volatile("s_waitcnt lgkmcnt(" #n ")" ::: "memory")
#define PG8_BAR __builtin_amdgcn_s_barrier()
#define PG8_SCHED __builtin_amdgcn_sched_barrier(0)
    Unit cur, nxt; int ui = 0;
    if (!S.next(0, cur)) return;
    f32x4 acc[2][2][4][2];
#pragma unroll
    for (int a = 0; a < 2; ++a)
#pragma unroll
        for (int b = 0; b < 2; ++b)
#pragma unroll
            for (int m = 0; m < 4; ++m)
#pragma unroll
                for (int n = 0; n < 2; ++n) acc[a][b][m][n] = (f32x4){0.f, 0.f, 0.f, 0.f};
    bf16x8 At[4][2], B0[2][2], B1[2][2];
    const char* cA = (const char*)g.A + (size_t)cur.pm * tstep; const char* cB = (const char*)g.Bt + (size_t)cur.pn * tstep;
    PG8_STAGE(PG8_SB(0, 0), cB, voffB); PG8_STAGE(PG8_SB(0, 1), cB + hstep, voffB); PG8_STAGE(PG8_SA(0, 0), cA, voffA); PG8_STAGE(PG8_SA(0, 1), cA + hstep, voffA);
    if (wr == 1) PG8_BAR;
    PG8_WAIT_V(2); PG8_BAR;
    PG8_STAGE(PG8_SB(1, 0), cB + kstep, voffB); PG8_STAGE(PG8_SA(1, 0), cA + kstep, voffA); PG8_STAGE(PG8_SB(1, 1), cB + hstep + kstep, voffB);
    PG8_WAIT_V(6); PG8_BAR;
    for (;;) {
        const bool has_next = S.next(ui + 1, nxt);
        const char* nA = has_next ? (const char*)g.A + (size_t)nxt.pm * tstep : cA; const char* nB = has_next ? (const char*)g.Bt + (size_t)nxt.pn * tstep : cB;
        for (int t = 0; t < nt; t += 2) {
            const bool last = (t == nt - 2);
            const char* a1 = cA + (size_t)(t + 1) * kstep;
            const char* a2 = last ? nA : cA + (size_t)(t + 2) * kstep; const char* b2 = last ? nB : cB + (size_t)(t + 2) * kstep;
            const char* a3 = a2 + kstep; const char* b3 = b2 + kstep;
            if constexpr (Epi::HOOK) { if (t == Epi::HOOK_T) { E.mid(acc, cur, wr, wc, fr, fq); PG8_WAIT_V(0); PG8_SCHED; } }
            PG8_LDB(B0, 0, 0); PG8_LDB(B1, 0, 1); PG8_SCHED; PG8_LDA(At, 0, 0); PG8_STAGE(PG8_SA(1, 1), a1 + hstep, voffA);
            PG8_WAIT_V(8); PG8_WAIT_L(0); PG8_BAR; PG8_MMA(0, 0, At, B0); PG8_MMA(0, 1, At, B1); PG8_BAR; PG8_SCHED;
            PG8_LDA(At, 0, 1); PG8_STAGE(PG8_SB(0, 0), b2, voffB); PG8_STAGE(PG8_SB(0, 1), b2 + hstep, voffB); PG8_STAGE(PG8_SA(0, 0), a2, voffA);
            PG8_WAIT_V(8); PG8_WAIT_L(0); PG8_BAR; PG8_MMA(1, 0, At, B0); PG8_MMA(1, 1, At, B1); PG8_BAR; PG8_SCHED;
            PG8_LDB(B0, 1, 0); PG8_LDB(B1, 1, 1); PG8_SCHED; PG8_LDA(At, 1, 0); PG8_STAGE(PG8_SA(0, 1), a2 + hstep, voffA);
            PG8_WAIT_V(8); PG8_WAIT_L(0); PG8_BAR; PG8_MMA(0, 0, At, B0); PG8_MMA(0, 1, At, B1); PG8_BAR; PG8_SCHED;
            PG8_LDA(At, 1, 1); PG8_STAGE(PG8_SB(1, 0), b3, voffB); PG8_STAGE(PG8_SB(1, 1), b3 + hstep, voffB); PG8_STAGE(PG8_SA(1, 0), a3, voffA);
            PG8_WAIT_V(8); PG8_WAIT_L(0); PG8_BAR; PG8_MMA(1, 0, At, B0); PG8_MMA(1, 1, At, B1); PG8_BAR; PG8_SCHED;
        }
        if constexpr (ALIGN_EPI) { if (wr == 0) PG8_BAR; }
        E(acc, cur, wr, wc, fr, fq);
        if (!has_next) break;
#pragma unroll
        for (int a = 0; a < 2; ++a)
#pragma unroll
            for (int b = 0; b < 2; ++b)
#pragma unroll
                for (int m = 0; m < 4; ++m)
#pragma unroll
                    for (int n = 0; n < 2; ++n) acc[a][b][m][n] = (f32x4){0.f, 0.f, 0.f, 0.f};
        cur = nxt; cA = nA; cB = nB; ++ui;
        if constexpr (ALIGN_EPI) { if (wr == 1) PG8_BAR; }
    }
    PG8_WAIT_V(0);
    if constexpr (!ALIGN_EPI) { if (wr == 0) PG8_BAR; }
    PG8_BAR;
#undef PG8_SA
#undef PG8_SB
#undef PG8_STAGE
#undef PG8_LDA
#undef PG8_LDB
#undef PG8_MMA
#undef PG8_WAIT_V
#undef PG8_WAIT_L
#undef PG8_BAR
#undef PG8_SCHED
}
}

constexpr int NWAVES = 8, NTHR = NWAVES * 64;
constexpr size_t MiB = 1u << 20;
constexpr size_t WS_CTL = 0, CTL_ZERO_BYTES = 1 * MiB;
constexpr size_t WS_WIN = 2 * MiB, WS_WAB = 22 * MiB, WS_WOUT = 26 * MiB, WS_SS = 28 * MiB, WS_LSE = 29 * MiB;
constexpr size_t WS_XN = 32 * MiB, WS_PROJ = 96 * MiB, WS_G = 736 * MiB, WS_MG = 864 * MiB, WS_END = 928 * MiB;
static_assert(WS_XN + (size_t)MS * DM * 2 <= WS_PROJ && WS_PROJ + (size_t)MS * INC * 2 <= WS_G && WS_G + (size_t)MS * GW * 2 <= WS_MG && WS_MG + (size_t)MS * DM * 2 <= WS_END, "d_ws map");
static_assert(WS_LSE + (size_t)MS * NHA * 4 <= WS_XN, "lse map");
constexpr int LDS_BYTES = 147456;

#define LAS __attribute__((address_space(3)))
typedef unsigned short bf16;
typedef unsigned v4u __attribute__((ext_vector_type(4)));
typedef float f32x4 __attribute__((ext_vector_type(4)));
#define LDS_WAIT() asm volatile("s_waitcnt lgkmcnt(0)" ::: "memory")
__device__ __forceinline__ unsigned f2bf(float f) { unsigned u = __builtin_bit_cast(unsigned, f); return (u + 0x7fffu + ((u >> 16) & 1u)) >> 16; }
__device__ __forceinline__ unsigned pk2(float lo, float hi) { return f2bf(lo) | (f2bf(hi) << 16); }
__device__ __forceinline__ float bflo(unsigned u) { return __uint_as_float(u << 16); }
__device__ __forceinline__ float bfhi(unsigned u) { return __uint_as_float(u & 0xffff0000u); }
__device__ __forceinline__ float wave_sum(float v) {
#pragma unroll
    for (int o = 1; o < 64; o <<= 1) v += __shfl_xor(v, o);
    return v;
}

__device__ __forceinline__ void p0_transpose_item(const float* W, int K, int N, bf16* WT, int ldt, int koff, bool win, LAS float* scr, int item, int lane) {
    const int nblk = N / 32, kb = item / nblk, nb = item % nblk, k0 = 64 * kb, n0 = 32 * nb;
    const float sc = (win && ((n0 < C_KA) || (n0 >= C_QB && n0 < C_KB))) ? QSCALE : 1.0f;
#pragma unroll 8
    for (int i = 0; i < 32; ++i) { const int kk = 2 * i + (lane >> 5); scr[kk * 33 + (lane & 31)] = W[(size_t)(k0 + kk) * N + n0 + (lane & 31)] * sc; }
    LDS_WAIT(); asm volatile("" ::: "memory");
    const int c = lane & 7;
#pragma unroll
    for (int j = 0; j < 4; ++j) { const int n = (lane >> 3) + 8 * j; const LAS float* s = scr + (8 * c) * 33 + n;
        v4u o; o.x = pk2(s[0 * 33], s[1 * 33]); o.y = pk2(s[2 * 33], s[3 * 33]); o.z = pk2(s[4 * 33], s[5 * 33]); o.w = pk2(s[6 * 33], s[7 * 33]);
        *(v4u*)(WT + (size_t)(n0 + n) * ldt + koff + k0 + 8 * c) = o; }
    LDS_WAIT(); asm volatile("" ::: "memory");
}
__device__ __forceinline__ void rms_row_to_bf16(const float* xrow, const float* g, bf16* orow, int lane) {
    const f32x4* xr = (const f32x4*)xrow + lane; const f32x4* gr = (const f32x4*)g + lane;
    f32x4 v[4]; float s = 0.f;
#pragma unroll
    for (int j = 0; j < 4; ++j) { v[j] = xr[64 * j]; s += (v[j].x * v[j].x + v[j].y * v[j].y) + (v[j].z * v[j].z + v[j].w * v[j].w); }
    const float rstd = 1.f / sqrtf(wave_sum(s) * (1.f / DM) + RMS_EPS);
    unsigned long long* o8 = (unsigned long long*)orow + lane;
#pragma unroll
    for (int j = 0; j < 4; ++j) { const f32x4 gg = gr[64 * j];
        o8[64 * j] = (unsigned long long)pk2(v[j].x * rstd * gg.x, v[j].y * rstd * gg.y) | ((unsigned long long)pk2(v[j].z * rstd * gg.z, v[j].w * rstd * gg.w) << 32); }
}

__device__ __forceinline__ void ld_row64(const bf16* p, float (&f)[64]) {
#pragma unroll
    for (int c = 0; c < 8; ++c) { const v4u w = *(const v4u*)(p + 8 * c);
        f[8 * c + 0] = bflo(w.x); f[8 * c + 1] = bfhi(w.x); f[8 * c + 2] = bflo(w.y); f[8 * c + 3] = bfhi(w.y);
        f[8 * c + 4] = bflo(w.z); f[8 * c + 5] = bfhi(w.z); f[8 * c + 6] = bflo(w.w); f[8 * c + 7] = bfhi(w.w); }
}
__device__ __forceinline__ float dot_row64(const bf16* p, const float (&q)[64]) {
    float s0 = 0.f, s1 = 0.f;
#pragma unroll
    for (int c = 0; c < 8; ++c) { const v4u w = *(const v4u*)(p + 8 * c);
        s0 += q[8 * c + 0] * bflo(w.x); s1 += q[8 * c + 1] * bfhi(w.x); s0 += q[8 * c + 2] * bflo(w.y); s1 += q[8 * c + 3] * bfhi(w.y);
        s0 += q[8 * c + 4] * bflo(w.z); s1 += q[8 * c + 5] * bfhi(w.z); s0 += q[8 * c + 6] * bflo(w.w); s1 += q[8 * c + 7] * bfhi(w.w); }
    return s0 + s1;
}
__device__ __forceinline__ void axpy_row64(const bf16* p, float a, float (&o)[64]) {
#pragma unroll
    for (int c = 0; c < 8; ++c) { const v4u w = *(const v4u*)(p + 8 * c);
        o[8 * c + 0] += a * bflo(w.x); o[8 * c + 1] += a * bfhi(w.x); o[8 * c + 2] += a * bflo(w.y); o[8 * c + 3] += a * bfhi(w.y);
        o[8 * c + 4] += a * bflo(w.z); o[8 * c + 5] += a * bfhi(w.z); o[8 * c + 6] += a * bflo(w.w); o[8 * c + 7] += a * bfhi(w.w); }
}
__device__ __forceinline__ float siluf_(float x) { return x * __builtin_amdgcn_rcpf(1.0f + __builtin_amdgcn_exp2f(-x * LOG2E)); }

__device__ __forceinline__ void naive_attn_a(const bf16* P, bf16* G, float* LSE, long gtid, long nthr) {
    for (long idx = gtid; idx < (long)MS * NHA; idx += nthr) {
        const int hA = (int)(idx / MS), row = (int)(idx % MS), g = hA / 6, j = hA % 6;
        const int d = (g == 0) ? 1 : (g == 1 ? 4 : 16), L = SEQ / d;
        const int sb = row / SEQ, t = row % SEQ, mq = t / d, r = t % d;
        const float slope = exp2f(-8.0f * (float)(g + 3 * j + 1) / 18.0f) * LOG2E * (float)d;
        float q[64], o[64];
        ld_row64(P + (size_t)row * INC + C_QA + hA * 64, q);
#pragma unroll
        for (int e = 0; e < 64; ++e) o[e] = 0.f;
        float m = -1e30f, l = 0.f;
        const int lo = mq - 64 < 0 ? 0 : mq - 64, hi = mq + 64 > L - 1 ? L - 1 : mq + 64;
        for (int mk = lo; mk <= hi; ++mk) {
            const size_t krow = (size_t)(sb * SEQ + mk * d + r);
            const int off = mk > mq ? mk - mq : mq - mk;
            const float s = dot_row64(P + krow * INC + C_KA + hA * 64, q) - slope * (float)off;
            const float mn = fmaxf(m, s), cr = __builtin_amdgcn_exp2f(m - mn), p = __builtin_amdgcn_exp2f(s - mn);
            l = l * cr + p; m = mn;
#pragma unroll
            for (int e = 0; e < 64; ++e) o[e] *= cr;
            axpy_row64(P + krow * INC + C_VA + hA * 64, p, o);
        }
        const float rl = 1.0f / l;
        bf16* op = G + (size_t)row * GW + hA * 64;
#pragma unroll
        for (int c = 0; c < 8; ++c) { v4u w; w.x = pk2(o[8 * c] * rl, o[8 * c + 1] * rl); w.y = pk2(o[8 * c + 2] * rl, o[8 * c + 3] * rl); w.z = pk2(o[8 * c + 4] * rl, o[8 * c + 5] * rl); w.w = pk2(o[8 * c + 6] * rl, o[8 * c + 7] * rl); *(v4u*)(op + 8 * c) = w; }
        LSE[(size_t)row * NHA + hA] = m + log2f(l);
    }
}
__device__ __forceinline__ void naive_attn_b(const bf16* P, bf16* G, const float* rpb, long gtid, long nthr) {
    for (long idx = gtid; idx < (long)MS * NHB; idx += nthr) {
        const int h = (int)(idx / MS), row = (int)(idx % MS);
        const int sb = row / SEQ, t = row % SEQ, r = t / 64, c = t % 64;
        const int rs = r - 4 < 0 ? 0 : (r - 4 > 24 ? 24 : r - 4), cs = c - 8 < 0 ? 0 : (c - 8 > 48 ? 48 : c - 8);
        float q[64], o[64];
        ld_row64(P + (size_t)row * INC + C_QB + h * 64, q);
#pragma unroll
        for (int e = 0; e < 64; ++e) o[e] = 0.f;
        float m = -1e30f, l = 0.f;
        for (int kk = 0; kk < 128; ++kk) {
            const int kr = rs + (kk >> 4), kc = cs + (kk & 15);
            const size_t krow = (size_t)(sb * SEQ + kr * 64 + kc);
            const float bias = rpb[(h * 15 + (kr - r + 7)) * 31 + (kc - c + 15)] * LOG2E;
            const float s = dot_row64(P + krow * INC + C_KB + h * 64, q) + bias;
            const float mn = fmaxf(m, s), cr = __builtin_amdgcn_exp2f(m - mn), p = __builtin_amdgcn_exp2f(s - mn);
            l = l * cr + p; m = mn;
#pragma unroll
            for (int e = 0; e < 64; ++e) o[e] *= cr;
            axpy_row64(P + krow * INC + C_VB + h * 64, p, o);
        }
        const float rl = 1.0f / l;
        float z[64]; ld_row64(P + (size_t)row * INC + C_ZB + h * 64, z);
        bf16* op = G + (size_t)row * GW + WA + h * 64;
#pragma unroll
        for (int cc = 0; cc < 8; ++cc) { v4u w;
            w.x = pk2(o[8 * cc] * rl * siluf_(z[8 * cc]), o[8 * cc + 1] * rl * siluf_(z[8 * cc + 1])); w.y = pk2(o[8 * cc + 2] * rl * siluf_(z[8 * cc + 2]), o[8 * cc + 3] * rl * siluf_(z[8 * cc + 3]));
            w.z = pk2(o[8 * cc + 4] * rl * siluf_(z[8 * cc + 4]), o[8 * cc + 5] * rl * siluf_(z[8 * cc + 5])); w.w = pk2(o[8 * cc + 6] * rl * siluf_(z[8 * cc + 6]), o[8 * cc + 7] * rl * siluf_(z[8 * cc + 7]));
            *(v4u*)(op + 8 * cc) = w; }
    }
}
__device__ __forceinline__ void combine_a(const bf16* P, bf16* G, const float* LSE, long gtid, long nthr) {
    for (long idx = gtid; idx < (long)MS * NHA * 8; idx += nthr) {
        const int c8 = (int)(idx & 7), hA = (int)((idx >> 3) % NHA), row = (int)((idx >> 3) / NHA), j = hA % 6;
        const float l0 = LSE[(size_t)row * NHA + j], l1 = LSE[(size_t)row * NHA + 6 + j], l2 = LSE[(size_t)row * NHA + 12 + j], lm = fmaxf(l0, fmaxf(l1, l2));
        const float e0 = __builtin_amdgcn_exp2f(l0 - lm), e1 = __builtin_amdgcn_exp2f(l1 - lm), e2 = __builtin_amdgcn_exp2f(l2 - lm);
        const float mine = hA < 6 ? e0 : (hA < 12 ? e1 : e2), alpha = mine / (e0 + e1 + e2);
        bf16* gp = G + (size_t)row * GW + hA * 64 + c8 * 8; const v4u o = *(const v4u*)gp, z = *(const v4u*)(P + (size_t)row * INC + C_ZA + hA * 64 + c8 * 8);
        v4u w; w.x = pk2(bflo(o.x) * alpha * siluf_(bflo(z.x)), bfhi(o.x) * alpha * siluf_(bfhi(z.x))); w.y = pk2(bflo(o.y) * alpha * siluf_(bflo(z.y)), bfhi(o.y) * alpha * siluf_(bfhi(z.y)));
        w.z = pk2(bflo(o.z) * alpha * siluf_(bflo(z.z)), bfhi(o.z) * alpha * siluf_(bfhi(z.z))); w.w = pk2(bflo(o.w) * alpha * siluf_(bflo(z.w)), bfhi(o.w) * alpha * siluf_(bfhi(z.w)));
        *(v4u*)gp = w;
    }
}


typedef short bf16x8v __attribute__((ext_vector_type(8)));
typedef float f32x16 __attribute__((ext_vector_type(16)));
typedef short s16x4 __attribute__((ext_vector_type(4)));
constexpr int ATT_VSLOT = 0, ATT_RPB = 65536, ATT_LSE = ATT_RPB + 26112, ATT_ITEM = ATT_LSE + 6144;
constexpr int NA_UNITS = SLAB_SEQ * 6 * 4;
constexpr int NB_ITEMS = SLAB_SEQ * NHB * 8;
__device__ __forceinline__ s16x4 vtr(LAS const char* p) { return __builtin_bit_cast(s16x4, __builtin_amdgcn_ds_read_tr16_b64_v4i16((LAS s16x4*)p)); }
__device__ __forceinline__ unsigned cvtpk(float lo, float hi) { unsigned r; asm volatile("v_cvt_pk_bf16_f32 %0, %1, %2" : "=v"(r) : "v"(lo), "v"(hi)); return r; }
__device__ __forceinline__ int clampi(int v, int lo, int hi) { return v < lo ? lo : (v > hi ? hi : v); }

__device__ __forceinline__ f32x16 qk_tile(const bf16x8v (&kf)[4], const bf16x8v (&qf)[4]) {
    f32x16 sT;
#pragma unroll
    for (int e = 0; e < 16; ++e) sT[e] = 0.f;
#pragma unroll
    for (int s4 = 0; s4 < 4; ++s4) sT = __builtin_amdgcn_mfma_f32_32x32x16_bf16(kf[s4], qf[s4], sT, 0, 0, 0);
    return sT;
}
__device__ __forceinline__ void softmax_pv(f32x16& sT, f32x16 (&oT)[2], float& m, float& l, LAS const char* vtrb) {
    float tm = fmaxf(fmaxf(sT[0], sT[1]), fmaxf(sT[2], sT[3]));
#pragma unroll
    for (int e = 4; e < 16; e += 4) tm = fmaxf(tm, fmaxf(fmaxf(sT[e], sT[e + 1]), fmaxf(sT[e + 2], sT[e + 3])));
    tm = fmaxf(tm, __shfl_xor(tm, 32));
    const float mn = fmaxf(m, tm), cr = __builtin_amdgcn_exp2f(m - mn); m = mn;
    float ps = 0.f;
#pragma unroll
    for (int e = 0; e < 16; ++e) { sT[e] = __builtin_amdgcn_exp2f(sT[e] - mn); ps += sT[e]; }
    l = l * cr + ps;
#pragma unroll
    for (int e = 0; e < 16; ++e) { oT[0][e] *= cr; oT[1][e] *= cr; }
    bf16x8v pf[2];
#pragma unroll
    for (int s2 = 0; s2 < 2; ++s2) { v4u w; w.x = cvtpk(sT[8 * s2 + 0], sT[8 * s2 + 1]); w.y = cvtpk(sT[8 * s2 + 2], sT[8 * s2 + 3]); w.z = cvtpk(sT[8 * s2 + 4], sT[8 * s2 + 5]); w.w = cvtpk(sT[8 * s2 + 6], sT[8 * s2 + 7]); pf[s2] = __builtin_bit_cast(bf16x8v, w); }
#pragma unroll
    for (int dt = 0; dt < 2; ++dt)
#pragma unroll
        for (int s2 = 0; s2 < 2; ++s2) { const s16x4 lo = vtr(vtrb + dt * 2048 + s2 * 1024), hi = vtr(vtrb + dt * 2048 + s2 * 1024 + 512);
            const bf16x8v vf = (bf16x8v){lo[0], lo[1], lo[2], lo[3], hi[0], hi[1], hi[2], hi[3]};
            oT[dt] = __builtin_amdgcn_mfma_f32_32x32x16_bf16(vf, pf[s2], oT[dt], 0, 0, 0); }
}
#define ATT_VWRITE(slot, vc) do { _Pragma("unroll") for (int i_ = 0; i_ < 4; ++i_) { const int idx_ = i_ * 64 + lane, key_ = idx_ >> 3, cc_ = idx_ & 7; \
        *(LAS v4u*)((slot) + (cc_ >> 2) * 2048 + key_ * 64 + (cc_ & 3) * 16) = vc[i_]; } } while (0)

__device__ __forceinline__ void attn_a_wave_unit(const bf16* P, bf16* G, LAS float* lseT, LAS char* vslots, int sb, int j, int c, int wu, int lane) {
    const int g = wu >> 4, u = wu & 15, dsh = 2 * g, d = 1 << dsh, Lq = SEQ >> dsh;
    const int r = u & (d - 1), n = u >> dsh, m0 = (512 >> dsh) * c + 32 * n, hA = g * 6 + j;
    const float slope_d = __builtin_amdgcn_exp2f(-8.0f * (float)(g + 3 * j + 1) / 18.0f) * LOG2E * (float)d;
    const int r32 = lane & 31, hi = lane >> 5;
    const size_t seqrow = (size_t)sb * SEQ;
    const int tq = (m0 + r32) * d + r;
    const bf16* qp = P + (seqrow + tq) * INC + C_QA + hA * 64 + 8 * hi;
    bf16x8v qf[4];
#pragma unroll
    for (int s4 = 0; s4 < 4; ++s4) qf[s4] = *(const bf16x8v*)(qp + 16 * s4);
    const bf16* kbase = P + seqrow * INC + C_KA + hA * 64 + 8 * hi; const bf16* vbase = P + seqrow * INC + C_VA + hA * 64;
    f32x16 oT[2];
#pragma unroll
    for (int e = 0; e < 16; ++e) { oT[0][e] = 0.f; oT[1][e] = 0.f; }
    float m = -1e30f, l = 0.f;
    bf16x8v kfn[4]; v4u vcn[4];
#define A_ISSUE(kt) do { const int mk_ = clampi(m0 - 64 + 32 * (kt) + r32, 0, Lq - 1); const bf16* kp_ = kbase + (size_t)(mk_ * d + r) * INC; \
        _Pragma("unroll") for (int s4 = 0; s4 < 4; ++s4) kfn[s4] = *(const bf16x8v*)(kp_ + 16 * s4); \
        _Pragma("unroll") for (int i_ = 0; i_ < 4; ++i_) { const int idx_ = i_ * 64 + lane, key_ = idx_ >> 3, cc_ = idx_ & 7; const int mv_ = clampi(m0 - 64 + 32 * (kt) + key_, 0, Lq - 1); \
            vcn[i_] = *(const v4u*)(vbase + (size_t)(mv_ * d + r) * INC + cc_ * 8); } } while (0)
    A_ISSUE(0);
    LAS const char* vtr0 = vslots + ((lane >> 4) & 1) * 32 + (lane & 3) * 8 + (4 * hi + ((lane & 15) >> 2)) * 64;
    for (int kt = 0; kt < 5; ++kt) {
        bf16x8v kf[4]; v4u vc[4];
#pragma unroll
        for (int s4 = 0; s4 < 4; ++s4) { kf[s4] = kfn[s4]; vc[s4] = vcn[s4]; }
        if (kt < 4) A_ISSUE(kt + 1);
        LAS char* slot = vslots + (kt & 1) * 4096;
        ATT_VWRITE(slot, vc);
        f32x16 sT = qk_tile(kf, qf);
        const int ob = 32 * kt - 64 - r32 + 4 * hi, mb = m0 - 64 + 32 * kt + 4 * hi;
#pragma unroll
        for (int e = 0; e < 16; ++e) { const int ko = (e & 3) + 8 * (e >> 2), off = ob + ko, mk = mb + ko, ao = off < 0 ? -off : off;
            const bool valid = (ao <= 64) && (mk >= 0) && (mk < Lq);
            sT[e] = valid ? sT[e] - slope_d * (float)ao : -1e30f; }
        softmax_pv(sT, oT, m, l, vtr0 + (kt & 1) * 4096);
    }
#undef A_ISSUE
    const float lt = l + __shfl_xor(l, 32), inv = 1.0f / lt;
    bf16* op = G + (seqrow + tq) * GW + hA * 64 + 4 * hi;
#pragma unroll
    for (int dt = 0; dt < 2; ++dt)
#pragma unroll
        for (int g4 = 0; g4 < 4; ++g4) { unsigned long long w = (unsigned long long)cvtpk(oT[dt][4 * g4] * inv, oT[dt][4 * g4 + 1] * inv) | ((unsigned long long)cvtpk(oT[dt][4 * g4 + 2] * inv, oT[dt][4 * g4 + 3] * inv) << 32);
            *(unsigned long long*)(op + 32 * dt + 8 * g4) = w; }
    if (hi == 0) lseT[(tq - 512 * c) * 3 + g] = m + __builtin_amdgcn_logf(lt);
}
__device__ __forceinline__ void attn_b_wave_unit(const bf16* P, bf16* G, LAS const float* rpbL, LAS char* vslots, int sb, int h, int rp, int cb, int lane) {
    const int r32 = lane & 31, hi = lane >> 5;
    const int r0 = 2 * rp, qr = r0 + (r32 >> 4), qc = 16 * cb + (r32 & 15);
    const int rs_q = clampi(qr - 4, 0, 24), cs_q = clampi(qc - 8, 0, 48);
    const int rsA = clampi(r0 - 4, 0, 24), rsB = clampi(r0 - 3, 0, 24), nk = rsB - rsA + 8, s0 = clampi(16 * cb - 8, 0, 32);
    const size_t seqrow = (size_t)sb * SEQ;
    const int tq = qr * 64 + qc;
    const bf16* qp = P + (seqrow + tq) * INC + C_QB + h * 64 + 8 * hi;
    bf16x8v qf[4];
#pragma unroll
    for (int s4 = 0; s4 < 4; ++s4) qf[s4] = *(const bf16x8v*)(qp + 16 * s4);
    const bf16* kbase = P + (seqrow + s0) * INC + C_KB + h * 64 + 8 * hi; const bf16* vbase = P + (seqrow + s0) * INC + C_VB + h * 64;
    f32x16 oT[2];
#pragma unroll
    for (int e = 0; e < 16; ++e) { oT[0][e] = 0.f; oT[1][e] = 0.f; }
    float m = -1e30f, l = 0.f;
    bf16x8v kfn[4]; v4u vcn[4];
#define B_ISSUE(kt) do { const bf16* kp_ = kbase + (size_t)((rsA + (kt)) * 64 + r32) * INC; \
        _Pragma("unroll") for (int s4 = 0; s4 < 4; ++s4) kfn[s4] = *(const bf16x8v*)(kp_ + 16 * s4); \
        _Pragma("unroll") for (int i_ = 0; i_ < 4; ++i_) { const int idx_ = i_ * 64 + lane, key_ = idx_ >> 3, cc_ = idx_ & 7; \
            vcn[i_] = *(const v4u*)(vbase + (size_t)((rsA + (kt)) * 64 + key_) * INC + cc_ * 8); } } while (0)
    B_ISSUE(0);
    LAS const char* vtr0 = vslots + ((lane >> 4) & 1) * 32 + (lane & 3) * 8 + (4 * hi + ((lane & 15) >> 2)) * 64;
    for (int kt = 0; kt < nk; ++kt) {
        bf16x8v kf[4]; v4u vc[4];
#pragma unroll
        for (int s4 = 0; s4 < 4; ++s4) { kf[s4] = kfn[s4]; vc[s4] = vcn[s4]; }
        if (kt + 1 < nk) B_ISSUE(kt + 1);
        LAS char* slot = vslots + (kt & 1) * 4096;
        ATT_VWRITE(slot, vc);
        f32x16 sT = qk_tile(kf, qf);
        const int kr = rsA + kt; const bool rowv = (kr >= rs_q) && (kr < rs_q + 8);
        LAS const float* brow = rpbL + (h * 15 + (kr - qr + 7)) * 31;
#pragma unroll
        for (int e = 0; e < 16; ++e) { const int kc = s0 + 4 * hi + (e & 3) + 8 * (e >> 2);
            const bool valid = rowv && (kc >= cs_q) && (kc < cs_q + 16);
            const float bias = brow[clampi(kc - qc, -15, 15) + 15];
            sT[e] = valid ? sT[e] + bias : -1e30f; }
        softmax_pv(sT, oT, m, l, vtr0 + (kt & 1) * 4096);
    }
#undef B_ISSUE
    const float lt = l + __shfl_xor(l, 32), inv = 1.0f / lt;
    const bf16* zp = P + (seqrow + tq) * INC + C_ZB + h * 64 + 4 * hi;
    bf16* op = G + (seqrow + tq) * GW + WA + h * 64 + 4 * hi;
#pragma unroll
    for (int dt = 0; dt < 2; ++dt)
#pragma unroll
        for (int g4 = 0; g4 < 4; ++g4) { const unsigned long long z = *(const unsigned long long*)(zp + 32 * dt + 8 * g4); const unsigned zl = (unsigned)z, zh = (unsigned)(z >> 32);
            unsigned long long w = (unsigned long long)cvtpk(oT[dt][4 * g4] * inv * siluf_(bflo(zl)), oT[dt][4 * g4 + 1] * inv * siluf_(bfhi(zl))) |
                                   ((unsigned long long)cvtpk(oT[dt][4 * g4 + 2] * inv * siluf_(bflo(zh)), oT[dt][4 * g4 + 3] * inv * siluf_(bfhi(zh))) << 32);
            *(unsigned long long*)(op + 32 * dt + 8 * g4) = w; }
}
__device__ __forceinline__ void mixer_phase(LAS unsigned char* L, const bf16* P, bf16* G, const float* rpb, unsigned* ctr, int tid) {
    const int lane = tid & 63, wave = __builtin_amdgcn_readfirstlane(tid >> 6);
    LAS float* rpbL = (LAS float*)(L + ATT_RPB); LAS float* lseT = (LAS float*)(L + ATT_LSE); volatile LAS int* itemw = (volatile LAS int*)(L + ATT_ITEM);
    LAS char* vslots = (LAS char*)(L + ATT_VSLOT + wave * 8192);
    for (int i = tid; i < NHB * 15 * 31; i += NTHR) rpbL[i] = rpb[i] * LOG2E;
    for (;;) {
        __syncthreads();
        if (tid == 0) *itemw = (int)atomicAdd(ctr, 1u);
        __syncthreads();
        const int item = __builtin_amdgcn_readfirstlane(*itemw);
        if (item >= NA_UNITS + NB_ITEMS) break;
        if (item < NA_UNITS) {
            const int sb = item / 24, j = (item / 4) % 6, c = item & 3;
            for (int i = 0; i < 6; ++i) attn_a_wave_unit(P, G, lseT, vslots, sb, j, c, wave + 8 * i, lane);
            __syncthreads();
            const size_t row0 = (size_t)sb * SEQ + 512 * c;
            for (int e = tid; e < 512 * 24; e += NTHR) {
                const int tok = e / 24, rem = e - tok * 24, g = rem >> 3, c8 = rem & 7, hA = g * 6 + j;
                const float l0 = lseT[tok * 3], l1 = lseT[tok * 3 + 1], l2 = lseT[tok * 3 + 2], lm = fmaxf(l0, fmaxf(l1, l2));
                const float e0 = __builtin_amdgcn_exp2f(l0 - lm), e1 = __builtin_amdgcn_exp2f(l1 - lm), e2 = __builtin_amdgcn_exp2f(l2 - lm);
                const float alpha = (g == 0 ? e0 : (g == 1 ? e1 : e2)) / (e0 + e1 + e2);
                bf16* gp = G + (row0 + tok) * GW + hA * 64 + c8 * 8; const v4u o = *(const v4u*)gp, z = *(const v4u*)(P + (row0 + tok) * INC + C_ZA + hA * 64 + c8 * 8);
                v4u w; w.x = pk2(bflo(o.x) * alpha * siluf_(bflo(z.x)), bfhi(o.x) * alpha * siluf_(bfhi(z.x))); w.y = pk2(bflo(o.y) * alpha * siluf_(bflo(z.y)), bfhi(o.y) * alpha * siluf_(bfhi(z.y)));
                w.z = pk2(bflo(o.z) * alpha * siluf_(bflo(z.z)), bfhi(o.z) * alpha * siluf_(bfhi(z.z))); w.w = pk2(bflo(o.w) * alpha * siluf_(bflo(z.w)), bfhi(o.w) * alpha * siluf_(bfhi(z.w)));
                *(v4u*)gp = w;
            }
        } else {
            const int it = item - NA_UNITS, sb = it / (NHB * 8), h = (it >> 3) % NHB, pr = it & 7;
            attn_b_wave_unit(P, G, rpbL, vslots, sb, h, 2 * pr + (wave >> 2), wave & 3, lane);
        }
    }
}


#define XB_TMO      128
#define XB_XCNT(j)  (256  + 64 * (j))
#define XB_XSUB(j)  (1280 + 64 * (j))
#define XB_XGEN(j)  (2304 + 64 * (j))
#define XB_TOP      3328
#define XB_TOPGEN   3392
#define XCD_BAR_WORDS 3456
#define XB_SPIN_CAP (1u << 18)
__device__ __forceinline__ unsigned xb_ld(unsigned* p)              { return __hip_atomic_load(p, __ATOMIC_RELAXED, __HIP_MEMORY_SCOPE_AGENT); }
__device__ __forceinline__ unsigned xb_add(unsigned* p, unsigned v) { return __hip_atomic_fetch_add(p, v, __ATOMIC_RELAXED, __HIP_MEMORY_SCOPE_AGENT); }
__device__ __forceinline__ unsigned xb_xcc_id() { return (unsigned)__builtin_amdgcn_s_getreg((3 << 11) | 20) & 0xFu; }
#define XB_SPIN(cond, bar) do { unsigned _sp = 0; while (cond) { __builtin_amdgcn_s_sleep(1); \
    if ((++_sp & 255u) == 0u) { if (xb_ld(&(bar)[XB_TMO])) break; if (_sp > XB_SPIN_CAP) { atomicAdd(&(bar)[XB_TMO], 1u); break; } } } } while (0)
struct XcdBarrier { unsigned* bar; unsigned x; volatile LAS unsigned* st; };
__device__ __forceinline__ XcdBarrier xcd_barrier_post(unsigned* bar, volatile LAS unsigned* st) {
    XcdBarrier b; b.bar = bar; b.x = xb_xcc_id(); b.st = st;
    if (threadIdx.x == 0) (void)xb_add(&bar[XB_XCNT(b.x)], 1u);
    return b;
}
__device__ __forceinline__ void xcd_barrier_complete(unsigned* bar, unsigned x, unsigned& nloc, unsigned& nx) {
    const unsigned G = gridDim.x * gridDim.y * gridDim.z;
    unsigned sum, cnt, mine, sp = 0u;
    for (;;) {
        sum = 0u; cnt = 0u; mine = 0u;
#pragma unroll
        for (unsigned j = 0; j < 16; ++j) { const unsigned c = xb_ld(&bar[XB_XCNT(j)]); sum += c; cnt += (c > 0u) ? 1u : 0u; mine = (j == x) ? c : mine; }
        if (sum == G) break;
        __builtin_amdgcn_s_sleep(1);
        if ((++sp & 255u) == 0u) { if (xb_ld(&bar[XB_TMO])) break; if (sp > XB_SPIN_CAP) { atomicAdd(&bar[XB_TMO], 1u); break; } }
    }
    nloc = mine > 0u ? mine : 1u; nx = cnt > 0u ? cnt : 1u;
}
__device__ __forceinline__ void xcd_barrier(const XcdBarrier& b) {
    asm volatile("s_waitcnt vmcnt(0)" ::: "memory");
    __syncthreads();
    if (threadIdx.x == 0) {
        unsigned* bar = b.bar;
        __builtin_amdgcn_s_waitcnt(0);
        unsigned nloc = b.st[0], nx = b.st[1];
        if (nloc == 0u) { xcd_barrier_complete(bar, b.x, nloc, nx); b.st[0] = nloc; b.st[1] = nx; }
        const unsigned old = xb_add(&bar[XB_XSUB(b.x)], 1u);
        const unsigned gen = old / nloc;
        if (old + 1u == (gen + 1u) * nloc) {
            __builtin_amdgcn_fence(__ATOMIC_RELEASE, "agent");
            asm volatile("s_waitcnt vmcnt(0)" ::: "memory");
            const unsigned og = xb_add(&bar[XB_TOP], 1u);
            const unsigned tg = og / nx;
            if (og + 1u == (tg + 1u) * nx) xb_add(&bar[XB_TOPGEN], 1u);
            else XB_SPIN(xb_ld(&bar[XB_TOPGEN]) == tg, bar);
            __builtin_amdgcn_fence(__ATOMIC_ACQUIRE, "agent");
            xb_add(&bar[XB_XGEN(b.x)], 1u);
            asm volatile("s_waitcnt vmcnt(0)" ::: "memory");
        } else {
            XB_SPIN(xb_ld(&bar[XB_XGEN(b.x)]) == gen, bar);
            __builtin_amdgcn_fence(__ATOMIC_ACQUIRE, "agent");
            asm volatile("s_waitcnt vmcnt(0)" ::: "memory");
        }
    }
    __syncthreads();
}

struct Args { const float* in[10]; float* out; unsigned char* ws; };
__global__ void __launch_bounds__(NTHR, 2) fwd_megakernel(Args args) {
    extern __shared__ __attribute__((aligned(16))) unsigned char lds[];
    cg::grid_group grid = cg::this_grid();
    LAS unsigned char* L = (LAS unsigned char*)lds;
    volatile LAS unsigned* MISC = (volatile LAS unsigned*)(L + LDS_BYTES - 64);
    if (threadIdx.x < 16) MISC[threadIdx.x] = 0u;
    __syncthreads();
    XcdBarrier xbar = xcd_barrier_post((unsigned*)(args.ws + WS_CTL) + 4096, MISC + 8);
#define GRID_BAR() xcd_barrier(xbar)
    const int G = gridDim.x, bx = blockIdx.x;
    const int NGW = G * NWAVES; const long nthr = (long)G * NTHR;
#define PHASE_IDS() int tid = threadIdx.x; asm volatile("" : "+v"(tid)); const int lane = tid & 63, wave = __builtin_amdgcn_readfirstlane(tid >> 6), gw = bx * NWAVES + wave; const long gtid = (long)bx * NTHR + tid; (void)lane; (void)gw; (void)gtid
    unsigned char* ws = args.ws;
    const float *xp = args.in[0], *xs = args.in[1], *norm_pre = args.in[2], *w_in = args.in[3], *b_gate = args.in[4], *rpb = args.in[5], *w_pa = args.in[6], *w_pb = args.in[7], *w_out = args.in[8], *norm_post = args.in[9];
    bf16* WIN = (bf16*)(ws + WS_WIN); bf16* WAB = (bf16*)(ws + WS_WAB); bf16* WOUT = (bf16*)(ws + WS_WOUT);
    float* SS = (float*)(ws + WS_SS); float* LSE = (float*)(ws + WS_LSE); unsigned* CTR = (unsigned*)(ws + WS_CTL);
    bf16* XN = (bf16*)(ws + WS_XN); bf16* PROJ = (bf16*)(ws + WS_PROJ); bf16* GB_ = (bf16*)(ws + WS_G); bf16* MG = (bf16*)(ws + WS_MG);

    {
        PHASE_IDS();
        LAS float* scr = (LAS float*)(L + wave * 16384);
        constexpr int I_IN = (DM / 64) * (INC / 32), I_A = (WA / 64) * (DM / 32), I_B = (WB / 64) * (DM / 32), I_O = (DM / 64) * (DM / 32);
        for (int it = gw; it < I_IN + I_A + I_B + I_O; it += NGW) {
            int r = it;
            if (r < I_IN) { p0_transpose_item(w_in, DM, INC, WIN, DM, 0, true, scr, r, lane); continue; } r -= I_IN;
            if (r < I_A) { p0_transpose_item(w_pa, WA, DM, WAB, GW, 0, false, scr, r, lane); continue; } r -= I_A;
            if (r < I_B) { p0_transpose_item(w_pb, WB, DM, WAB, GW, WA, false, scr, r, lane); continue; } r -= I_B;
            p0_transpose_item(w_out, DM, DM, WOUT, DM, 0, false, scr, r, lane);
        }
        for (long i = gtid; i < MTOT; i += nthr) SS[i] = 0.f;
        if (gtid < 64) CTR[gtid] = 0u;
    }
    for (int s = 0; s < NSLAB; ++s) {
        const float* xsl = (s == 0) ? xp : xs + (size_t)(s - 1) * MS * DM;
        float* osl = args.out + (size_t)s * MS * DM;
        float* sssl = SS + (size_t)s * MS;
        const bf16 *XNp = XN, *WINp = WIN, *WABp = WAB, *WOUTp = WOUT, *MGp = MG; bf16* Gp = GB_;
        asm volatile("" : "+s"(XNp), "+s"(WINp), "+s"(WABp), "+s"(WOUTp), "+s"(MGp), "+s"(Gp));
        { PHASE_IDS(); for (int m = gw; m < MS; m += NGW) rms_row_to_bf16(xsl + (size_t)m * DM, norm_pre, XN + (size_t)m * DM, lane); }
        if (s == 0) grid.sync(); else GRID_BAR();
        { pg8::Gemm g{XNp, WINp, MS, INC, DM}; pg8::StaticOrder S; S.init(MS, INC, G, bx); pg8::EpiProj E{PROJ, b_gate};
          pg8::gemm_phase<pg8::EpiProj, pg8::StaticOrder>(L, g, S, E); }
        GRID_BAR();
#ifdef NAIVE_MIXERS
        { PHASE_IDS(); naive_attn_a(PROJ, GB_, LSE, gtid, nthr); }
        { PHASE_IDS(); naive_attn_b(PROJ, GB_, rpb, gtid, nthr); }
        GRID_BAR();
        { PHASE_IDS(); combine_a(PROJ, GB_, LSE, gtid, nthr); }
#else
        { PHASE_IDS(); mixer_phase(L, PROJ, GB_, rpb, CTR + s, tid); }
#endif
        GRID_BAR();
        { pg8::Gemm g{Gp, WABp, MS, DM, GW}; pg8::StaticOrder S; S.init(MS, DM, G, bx); pg8::EpiGate E{PROJ, MG};
          pg8::gemm_phase<pg8::EpiGate, pg8::StaticOrder>(L, g, S, E); }
        GRID_BAR();
        { pg8::Gemm g{MGp, WOUTp, MS, DM, DM}; pg8::StaticOrder S; S.init(MS, DM, G, bx); pg8::EpiOut E{osl, sssl};
          pg8::gemm_phase<pg8::EpiOut, pg8::StaticOrder>(L, g, S, E); }
        GRID_BAR();
        { PHASE_IDS();
        for (int m = gw; m < MS; m += NGW) {
            const float rstd = 1.f / sqrtf(sssl[m] * (1.f / DM) + RMS_EPS);
            const f32x4* xr = (const f32x4*)(xsl + (size_t)m * DM) + lane; f32x4* tr = (f32x4*)(osl + (size_t)m * DM) + lane; const f32x4* gr = (const f32x4*)norm_post + lane;
#pragma unroll
            for (int j = 0; j < 4; ++j) { const f32x4 t = tr[64 * j], x = xr[64 * j], gg = gr[64 * j]; tr[64 * j] = x + t * rstd * gg; }
        } }
    }
}

extern "C" void kernel_launch(void* const* d_in, const int* in_sizes, int n_in, void* d_out, int out_size, void* d_ws, size_t ws_size, hipStream_t stream) {
    static int grid = 0;
    if (grid == 0) {
        if (n_in != 10 || out_size != MTOT * DM || ws_size < WS_END) { fprintf(stderr, "kernel_launch: bad shapes: n_in %d out %d ws %zu (need %zu)\n", n_in, out_size, ws_size, (size_t)WS_END); grid = -1; return; }
        int dev = 0, cus = 0, per_cu = 0;
        hipGetDevice(&dev); hipDeviceGetAttribute(&cus, hipDeviceAttributeMultiprocessorCount, dev);
        if (hipFuncSetAttribute((const void*)fwd_megakernel, hipFuncAttributeMaxDynamicSharedMemorySize, LDS_BYTES) != hipSuccess) { fprintf(stderr, "kernel_launch: hipFuncSetAttribute failed\n"); grid = -1; return; }
        hipOccupancyMaxActiveBlocksPerMultiprocessor(&per_cu, (const void*)fwd_megakernel, NTHR, LDS_BYTES);
        if (per_cu < 1) { fprintf(stderr, "kernel_launch: occupancy query says %d blocks per CU\n", per_cu); per_cu = 1; }
        (void)hipGetLastError();
        grid = cus;
    }
    if (grid < 0) return;
    if (hipMemsetAsync((char*)d_ws + WS_CTL, 0, 65536, stream) != hipSuccess) { fprintf(stderr, "kernel_launch: memset failed\n"); return; }
    Args a{};
    for (int i = 0; i < 10; ++i) a.in[i] = (const float*)d_in[i];
    a.out = (float*)d_out; a.ws = (unsigned char*)d_ws;
    void* kargs[] = {&a};
    hipError_t e = hipLaunchCooperativeKernel((const void*)fwd_megakernel, dim3(grid), dim3(NTHR), kargs, LDS_BYTES, stream);
    if (e != hipSuccess) fprintf(stderr, "cooperative launch failed: %s (grid %d)\n", hipGetErrorString(e), grid);
}
```

```cpp
#include <hip/hip_runtime.h>
#include <hip/hip_cooperative_groups.h>
#include <cstdio>
#include <cstdint>
namespace cg = cooperative_groups;

constexpr int DM = 1024, SEQ = 2048, NSEQ = 48, MTOT = NSEQ * SEQ;
constexpr int SLAB_SEQ = 16, MS = SLAB_SEQ * SEQ, NSLAB = NSEQ / SLAB_SEQ;
constexpr int WA = 1152, WB = 896, INC = 10240, GW = WA + WB;
constexpr int C_QA = 0, C_KA = 1152, C_VA = 2304, C_ZA = 3456, C_QB = 4608, C_KB = 5504, C_VB = 6400, C_ZB = 7296, C_GA = 8192, C_GB = 9216;
constexpr int NHA = 18, NHB = 14;
constexpr int H_QA = 0, H_KA = 18, H_VA = 36, H_ZA = 54, H_QB = 72, H_KB = 86, H_VB = 100, H_ZB = 114, GPITCH = 2048;
constexpr size_t PG_OFF = (size_t)128 * MS * 64;
constexpr float LOG2E = 1.4426950408889634f;
constexpr float QSCALE = 0.125f * LOG2E;
constexpr float RMS_EPS = 1e-6f;

namespace pg8 {
#define PG8_LAS __attribute__((address_space(3)))
typedef unsigned short bf16_t;
typedef short bf16x8 __attribute__((ext_vector_type(8)));
typedef float f32x4 __attribute__((ext_vector_type(4)));
typedef unsigned u32x4 __attribute__((ext_vector_type(4)));
constexpr int BM = 256, BK = 64, HALF = 128, HTB = HALF * BK * 2, STAGE_BYTES = 8 * HTB, NXCD = 8, WGM = 8;

__host__ __device__ __forceinline__ int lds_byte(int r, int c) { const int st = (r >> 4) * 2 + (c >> 5), rr = r & 15, cc = c & 31, ob = rr * 64 + cc * 2; return st * 1024 + (ob ^ (((ob >> 9) & 1) << 5)); }
__host__ __device__ __forceinline__ void stage_rc(int b, int& R, int& C) { const int st = b / 1024, sb = b % 1024, swz = sb ^ (((sb >> 9) & 1) << 5); R = (st >> 1) * 16 + swz / 64; C = (st & 1) * 32 + (swz % 64) / 2; }
__host__ __device__ __forceinline__ int perm32(int rho) { const int n = rho >> 4, i = rho & 15; return 8 * (i >> 2) + 4 * n + (i & 3); }

struct Unit { int pm, pn; };
struct Gemm { const bf16_t* A; const bf16_t* Bt; int M, N, K; };

struct StaticOrder {
    int nM, nN, nwg, G, c;
    __host__ __device__ void init(int M, int N, int G_, int c_) { nM = M / BM; nN = N / BM; nwg = nM * nN; G = G_; c = c_; }
    __host__ __device__ bool next(int i, Unit& u) const {
        const long L = (long)i * G + c; if (L >= nwg) return false;
        int wgid = (int)L; { const int q = nwg / NXCD, r = nwg % NXCD, xcd = wgid % NXCD, off = wgid / NXCD; wgid = (xcd < r ? xcd * (q + 1) : r * (q + 1) + (xcd - r) * q) + off; }
        const int nig = WGM * nN, gid = wgid / nig, fm = gid * WGM, gsz = (nM - fm) < WGM ? (nM - fm) : WGM;
        u.pm = fm + ((wgid % nig) % gsz); u.pn = (wgid % nig) / gsz; return true;
    }
};

__device__ __forceinline__ unsigned cvt_pk_bf16(float lo, float hi) { unsigned r; asm volatile("v_cvt_pk_bf16_f32 %0, %1, %2" : "=v"(r) : "v"(lo), "v"(hi)); return r; }
__device__ __forceinline__ float bf_lo(unsigned u) { return __uint_as_float(u << 16); }
__device__ __forceinline__ float bf_hi(unsigned u) { return __uint_as_float(u & 0xffff0000u); }
__device__ __forceinline__ float sigmoidf_(float x) { return __builtin_amdgcn_rcpf(1.0f + __builtin_amdgcn_exp2f(-x * LOG2E)); }

struct EpiProj {
    static constexpr bool PERM = true, HOOK = false; static constexpr int HOOK_T = -1;
    bf16_t* O; const float* bgate;
    __device__ __forceinline__ void mid(f32x4 (&acc)[2][2][4][2], const Unit& u, int wr, int wc, int fr, int fq) const {}
    __device__ __forceinline__ void operator()(const f32x4 (&acc)[2][2][4][2], const Unit& u, int wr, int wc, int fr, int fq) const {
        const int row0 = u.pm * BM + wr * 64 + fr; const int col0 = u.pn * BM + wc * 32 + 8 * fq;
        const bool gate = u.pn >= 32;
        f32x4 bv[2][2];
#pragma unroll
        for (int bj = 0; bj < 2; ++bj)
#pragma unroll
            for (int n = 0; n < 2; ++n) bv[bj][n] = gate ? *(const f32x4*)(bgate + (col0 - C_GA) + bj * HALF + 4 * n) : (f32x4){0.f, 0.f, 0.f, 0.f};
#pragma unroll
        for (int ai = 0; ai < 2; ++ai)
#pragma unroll
            for (int m = 0; m < 4; ++m) { const int row = row0 + ai * HALF + m * 16;
#pragma unroll
                for (int bj = 0; bj < 2; ++bj) { f32x4 v0 = acc[ai][bj][m][0], v1 = acc[ai][bj][m][1];
                    const int c = col0 + bj * HALF;
                    bf16_t* dst;
                    if (gate) { v0 = v0 + bv[bj][0]; v1 = v1 + bv[bj][1];
#pragma unroll
                        for (int e = 0; e < 4; ++e) { v0[e] = sigmoidf_(v0[e]); v1[e] = sigmoidf_(v1[e]); }
                        dst = O + PG_OFF + (size_t)row * GPITCH + (c - C_GA); }
                    else dst = O + ((size_t)(c >> 6) * MS + row) * 64 + (c & 63);
                    u32x4 w; w.x = cvt_pk_bf16(v0[0], v0[1]); w.y = cvt_pk_bf16(v0[2], v0[3]); w.z = cvt_pk_bf16(v1[0], v1[1]); w.w = cvt_pk_bf16(v1[2], v1[3]);
                    *(u32x4*)dst = w; } }
    }
};
struct EpiGate {
    static constexpr bool PERM = true, HOOK = true; static constexpr int HOOK_T = WA / BK;
    const bf16_t* P; bf16_t* O;
    __device__ __forceinline__ void mid(f32x4 (&acc)[2][2][4][2], const Unit& u, int wr, int wc, int fr, int fq) const {
        int z = 0; asm volatile("" : "+v"(z));
        const unsigned off0 = (unsigned)(((u.pm * BM + wr * 64 + fr + z) * GPITCH + u.pn * BM + wc * 32 + 8 * fq) * 2);
        const char* pb = (const char*)(P + PG_OFF);
#pragma unroll
        for (int ai = 0; ai < 2; ++ai)
#pragma unroll
            for (int m = 0; m < 4; ++m) { const unsigned off = off0 + (unsigned)((ai * HALF + m * 16) * GPITCH * 2);
#pragma unroll
                for (int bj = 0; bj < 2; ++bj) {
                    const u32x4 a = *(const u32x4*)(pb + off + (bj * HALF) * 2), b = *(const u32x4*)(pb + off + (DM + bj * HALF) * 2);
                    f32x4 r0, r1;
                    r0[0] = bf_lo(a.x) * __builtin_amdgcn_rcpf(bf_lo(b.x)); r0[1] = bf_hi(a.x) * __builtin_amdgcn_rcpf(bf_hi(b.x));
                    r0[2] = bf_lo(a.y) * __builtin_amdgcn_rcpf(bf_lo(b.y)); r0[3] = bf_hi(a.y) * __builtin_amdgcn_rcpf(bf_hi(b.y));
                    r1[0] = bf_lo(a.z) * __builtin_amdgcn_rcpf(bf_lo(b.z)); r1[1] = bf_hi(a.z) * __builtin_amdgcn_rcpf(bf_hi(b.z));
                    r1[2] = bf_lo(a.w) * __builtin_amdgcn_rcpf(bf_lo(b.w)); r1[3] = bf_hi(a.w) * __builtin_amdgcn_rcpf(bf_hi(b.w));
                    acc[ai][bj][m][0] = acc[ai][bj][m][0] * r0; acc[ai][bj][m][1] = acc[ai][bj][m][1] * r1; }
                asm volatile("" ::: "memory"); }
    }
    __device__ __forceinline__ void operator()(const f32x4 (&acc)[2][2][4][2], const Unit& u, int wr, int wc, int fr, int fq) const {
        const int row0 = u.pm * BM + wr * 64 + fr; const int col0 = u.pn * BM + wc * 32 + 8 * fq;
#pragma unroll
        for (int ai = 0; ai < 2; ++ai)
#pragma unroll
            for (int m = 0; m < 4; ++m) { const size_t row = (size_t)(row0 + ai * HALF + m * 16); const bf16_t* gp = P + PG_OFF + row * GPITCH + DM + col0; bf16_t* op = O + row * DM + col0;
#pragma unroll
                for (int bj = 0; bj < 2; ++bj) { const u32x4 b = *(const u32x4*)(gp + bj * HALF);
                    const f32x4 v0 = acc[ai][bj][m][0], v1 = acc[ai][bj][m][1];
                    u32x4 w; w.x = cvt_pk_bf16(v0[0] * bf_lo(b.x), v0[1] * bf_hi(b.x)); w.y = cvt_pk_bf16(v0[2] * bf_lo(b.y), v0[3] * bf_hi(b.y));
                    w.z = cvt_pk_bf16(v1[0] * bf_lo(b.z), v1[1] * bf_hi(b.z)); w.w = cvt_pk_bf16(v1[2] * bf_lo(b.w), v1[3] * bf_hi(b.w));
                    *(u32x4*)(op + bj * HALF) = w; } }
    }
};
struct EpiOut {
    static constexpr bool PERM = true, HOOK = false; static constexpr int HOOK_T = -1;
    float* T; float* ss;
    __device__ __forceinline__ void mid(f32x4 (&acc)[2][2][4][2], const Unit& u, int wr, int wc, int fr, int fq) const {}
    __device__ __forceinline__ void operator()(const f32x4 (&acc)[2][2][4][2], const Unit& u, int wr, int wc, int fr, int fq) const {
        const int row0 = u.pm * BM + wr * 64 + fr; const int col0 = u.pn * BM + wc * 32 + 8 * fq;
#pragma unroll
        for (int ai = 0; ai < 2; ++ai)
#pragma unroll
            for (int m = 0; m < 4; ++m) { const size_t row = (size_t)(row0 + ai * HALF + m * 16); float* op = T + row * DM + col0; float s = 0.f;
#pragma unroll
                for (int bj = 0; bj < 2; ++bj) { const f32x4 v0 = acc[ai][bj][m][0], v1 = acc[ai][bj][m][1];
                    s += (v0[0] * v0[0] + v0[1] * v0[1]) + (v0[2] * v0[2] + v0[3] * v0[3]) + (v1[0] * v1[0] + v1[1] * v1[1]) + (v1[2] * v1[2] + v1[3] * v1[3]);
                    *(f32x4*)(op + bj * HALF) = v0; *(f32x4*)(op + bj * HALF + 4) = v1; }
                s += __shfl_xor(s, 16); s += __shfl_xor(s, 32);
                if (fq == 0) atomicAdd(ss + row, s); }
    }
};

template <class Epi, class Sched, bool ALIGN_EPI = true>
__device__ __forceinline__ void gemm_phase(PG8_LAS unsigned char* lds, const Gemm g, const Sched& S, const Epi& E, int tid) {
    asm volatile("" : "+v"(tid));
    const int wid = __builtin_amdgcn_readfirstlane(tid >> 6), lane = tid & 63, wr = wid >> 2, wc = wid & 3, fr = lane & 15, fq = lane >> 4;
    const int K = g.K, nt = K / BK;
    unsigned voffA[2], voffB[2];
#pragma unroll
    for (int i = 0; i < 2; ++i) { int R, C; stage_rc(tid * 16 + i * 8192, R, C); const int Rb = Epi::PERM ? ((R & ~31) + perm32(R & 31)) : R;
        voffA[i] = (unsigned)(R * K + C) * 2u; voffB[i] = (unsigned)(Rb * K + C) * 2u; }
    const size_t kstep = (size_t)(BK * 2);
    const size_t hstep = (size_t)HALF * K * 2;
    const size_t tstep = 2 * hstep;
    const unsigned ldsw = (unsigned)wid * 1024u;
    const int aoff = lds_byte(wr * 64 + fr, fq * 8), boff = lds_byte(wc * 32 + fr, fq * 8);
#define PG8_SA(b, h) (((b) * 2 + (h)) * HTB)
#define PG8_SB(b, h) ((4 + (b) * 2 + (h)) * HTB)
#define PG8_STAGE(bufoff, gbase, voff) do { _Pragma("unroll") for (int _i = 0; _i < 2; ++_i) \
        __builtin_amdgcn_global_load_lds((const unsigned*)((const char*)(gbase) + (voff)[_i]), (PG8_LAS unsigned*)(lds + (bufoff) + ldsw + _i * 8192), 16, 0, 0); } while (0)
#define PG8_LDA(dst, b, h) do { _Pragma("unroll") for (int m = 0; m < 4; ++m) _Pragma("unroll") for (int k = 0; k < 2; ++k) dst[m][k] = *(const PG8_LAS bf16x8*)(lds + PG8_SA(b, h) + aoff + m * 2048 + k * 1024); } while (0)
#define PG8_LDB(dst, b, h) do { _Pragma("unroll") for (int n = 0; n < 2; ++n) _Pragma("unroll") for (int k = 0; k < 2; ++k) dst[n][k] = *(const PG8_LAS bf16x8*)(lds + PG8_SB(b, h) + boff + n * 2048 + k * 1024); } while (0)
#define PG8_MMA(ai, bj, At, Bt) do { __builtin_amdgcn_s_setprio(1); _Pragma("unroll") for (int m = 0; m < 4; ++m) _Pragma("unroll") for (int n = 0; n < 2; ++n) _Pragma("unroll") for (int k = 0; k < 2; ++k) \
        acc[ai][bj][m][n] = __builtin_amdgcn_mfma_f32_16x16x32_bf16(Bt[n][k], At[m][k], acc[ai][bj][m][n], 0, 0, 0); __builtin_amdgcn_s_setprio(0); } while (0)
#define PG8_WAIT_V(n) asm volatile("s_waitcnt vmcnt(" #n ")" ::: "memory")
#define PG8_WAIT_L(n) asm volatile("s_waitcnt lgkmcnt(" #n ")" ::: "memory")
#define PG8_BAR __builtin_amdgcn_s_barrier()
#define PG8_SCHED __builtin_amdgcn_sched_barrier(0)
    Unit cur, nxt; int ui = 0;
    if (!S.next(0, cur)) return;
    f32x4 acc[2][2][4][2];
#pragma unroll
    for (int a = 0; a < 2; ++a)
#pragma unroll
        for (int b = 0; b < 2; ++b)
#pragma unroll
            for (int m = 0; m < 4; ++m)
#pragma unroll
                for (int n = 0; n < 2; ++n) acc[a][b][m][n] = (f32x4){0.f, 0.f, 0.f, 0.f};
    bf16x8 At[4][2], B0[2][2], B1[2][2];
    const char* cA = (const char*)g.A + (size_t)cur.pm * tstep; const char* cB = (const char*)g.Bt + (size_t)cur.pn * tstep;
    PG8_STAGE(PG8_SB(0, 0), cB, voffB); PG8_STAGE(PG8_SB(0, 1), cB + hstep, voffB); PG8_STAGE(PG8_SA(0, 0), cA, voffA); PG8_STAGE(PG8_SA(0, 1), cA + hstep, voffA);
    if (wr == 1) PG8_BAR;
    PG8_WAIT_V(2); PG8_BAR;
    PG8_STAGE(PG8_SB(1, 0), cB + kstep, voffB); PG8_STAGE(PG8_SA(1, 0), cA + kstep, voffA); PG8_STAGE(PG8_SB(1, 1), cB + hstep + kstep, voffB);
    PG8_WAIT_V(6); PG8_BAR;
    for (;;) {
        const bool has_next = S.next(ui + 1, nxt);
        const char* nA = has_next ? (const char*)g.A + (size_t)nxt.pm * tstep : cA; const char* nB = has_next ? (const char*)g.Bt + (size_t)nxt.pn * tstep : cB;
        for (int t = 0; t < nt; t += 2) {
            const bool last = (t == nt - 2);
            const char* a1 = cA + (size_t)(t + 1) * kstep;
            const char* a2 = last ? nA : cA + (size_t)(t + 2) * kstep; const char* b2 = last ? nB : cB + (size_t)(t + 2) * kstep;
            const char* a3 = a2 + kstep; const char* b3 = b2 + kstep;
            if constexpr (Epi::HOOK) { if (t == Epi::HOOK_T) { E.mid(acc, cur, wr, wc, fr, fq); PG8_WAIT_V(0); PG8_SCHED; } }
            PG8_LDB(B0, 0, 0); PG8_LDB(B1, 0, 1); PG8_SCHED; PG8_LDA(At, 0, 0); PG8_STAGE(PG8_SA(1, 1), a1 + hstep, voffA);
            PG8_WAIT_V(8); PG8_WAIT_L(0); PG8_BAR; PG8_MMA(0, 0, At, B0); PG8_MMA(0, 1, At, B1); PG8_BAR; PG8_SCHED;
            PG8_LDA(At, 0, 1); PG8_STAGE(PG8_SB(0, 0), b2, voffB); PG8_STAGE(PG8_SB(0, 1), b2 + hstep, voffB); PG8_STAGE(PG8_SA(0, 0), a2, voffA);
            PG8_WAIT_V(8); PG8_WAIT_L(0); PG8_BAR; PG8_MMA(1, 0, At, B0); PG8_MMA(1, 1, At, B1); PG8_BAR; PG8_SCHED;
            PG8_LDB(B0, 1, 0); PG8_LDB(B1, 1, 1); PG8_SCHED; PG8_LDA(At, 1, 0); PG8_STAGE(PG8_SA(0, 1), a2 + hstep, voffA);
            PG8_WAIT_V(8); PG8_WAIT_L(0); PG8_BAR; PG8_MMA(0, 0, At, B0); PG8_MMA(0, 1, At, B1); PG8_BAR; PG8_SCHED;
            PG8_LDA(At, 1, 1); PG8_STAGE(PG8_SB(1, 0), b3, voffB); PG8_STAGE(PG8_SB(1, 1), b3 + hstep, voffB); PG8_STAGE(PG8_SA(1, 0), a3, voffA);
            PG8_WAIT_V(8); PG8_WAIT_L(0); PG8_BAR; PG8_MMA(1, 0, At, B0); PG8_MMA(1, 1, At, B1); PG8_BAR; PG8_SCHED;
        }
        if constexpr (ALIGN_EPI) { if (wr == 0) PG8_BAR; }
        E(acc, cur, wr, wc, fr, fq);
        if (!has_next) break;
#pragma unroll
        for (int a = 0; a < 2; ++a)
#pragma unroll
            for (int b = 0; b < 2; ++b)
#pragma unroll
                for (int m = 0; m < 4; ++m)
#pragma unroll
                    for (int n = 0; n < 2; ++n) acc[a][b][m][n] = (f32x4){0.f, 0.f, 0.f, 0.f};
        cur = nxt; cA = nA; cB = nB; ++ui;
        if constexpr (ALIGN_EPI) { if (wr == 1) PG8_BAR; }
    }
    PG8_WAIT_V(0);
    if constexpr (!ALIGN_EPI) { if (wr == 0) PG8_BAR; }
    PG8_BAR;
#undef PG8_SA
#undef PG8_SB
#undef PG8_STAGE
#undef PG8_LDA
#undef PG8_LDB
#undef PG8_MMA
#undef PG8_WAIT_V
#undef PG8_WAIT_L
#undef PG8_BAR
#undef PG8_SCHED
}
}

constexpr int NWAVES = 8, NTHR = NWAVES * 64;
constexpr size_t MiB = 1u << 20;
constexpr size_t WS_CTL = 0, CTL_ZERO_BYTES = 1 * MiB;
constexpr size_t WS_WIN = 2 * MiB, WS_WAB = 22 * MiB, WS_WOUT = 26 * MiB, WS_SS = 28 * MiB, WS_LSE = 29 * MiB;
constexpr size_t WS_XN = 32 * MiB, WS_PROJ = 96 * MiB, WS_G = 736 * MiB, WS_MG = 864 * MiB, WS_END = 928 * MiB;
static_assert(WS_XN + (size_t)MS * DM * 2 <= WS_PROJ && WS_PROJ + (size_t)MS * INC * 2 <= WS_G && WS_G + (size_t)MS * GW * 2 <= WS_MG && WS_MG + (size_t)MS * DM * 2 <= WS_END, "d_ws map");
static_assert(WS_LSE + (size_t)MS * NHA * 4 <= WS_XN, "lse map");
constexpr int LDS_BYTES = 147456;

#define LAS __attribute__((address_space(3)))
typedef unsigned short bf16;
typedef unsigned v4u __attribute__((ext_vector_type(4)));
typedef float f32x4 __attribute__((ext_vector_type(4)));
#define LDS_WAIT() asm volatile("s_waitcnt lgkmcnt(0)" ::: "memory")
__device__ __forceinline__ unsigned f2bf(float f) { unsigned u = __builtin_bit_cast(unsigned, f); return (u + 0x7fffu + ((u >> 16) & 1u)) >> 16; }
__device__ __forceinline__ unsigned pk2(float lo, float hi) { return f2bf(lo) | (f2bf(hi) << 16); }
__device__ __forceinline__ float bflo(unsigned u) { return __uint_as_float(u << 16); }
__device__ __forceinline__ float bfhi(unsigned u) { return __uint_as_float(u & 0xffff0000u); }
__device__ __forceinline__ float wave_sum(float v) {
#pragma unroll
    for (int o = 1; o < 64; o <<= 1) v += __shfl_xor(v, o);
    return v;
}

__device__ __forceinline__ void p0_transpose_item(const float* W, int K, int N, bf16* WT, int ldt, int koff, bool win, LAS float* scr, int item, int lane) {
    const int nblk = N / 32, kb = item / nblk, nb = item % nblk, k0 = 64 * kb, n0 = 32 * nb;
    const float sc = (win && ((n0 < C_KA) || (n0 >= C_QB && n0 < C_KB))) ? QSCALE : 1.0f;
#pragma unroll 8
    for (int i = 0; i < 32; ++i) { const int kk = 2 * i + (lane >> 5); scr[kk * 33 + (lane & 31)] = W[(size_t)(k0 + kk) * N + n0 + (lane & 31)] * sc; }
    LDS_WAIT(); asm volatile("" ::: "memory");
    const int c = lane & 7;
#pragma unroll
    for (int j = 0; j < 4; ++j) { const int n = (lane >> 3) + 8 * j; const LAS float* s = scr + (8 * c) * 33 + n;
        v4u o; o.x = pk2(s[0 * 33], s[1 * 33]); o.y = pk2(s[2 * 33], s[3 * 33]); o.z = pk2(s[4 * 33], s[5 * 33]); o.w = pk2(s[6 * 33], s[7 * 33]);
        *(v4u*)(WT + (size_t)(n0 + n) * ldt + koff + k0 + 8 * c) = o; }
    LDS_WAIT(); asm volatile("" ::: "memory");
}
__device__ __forceinline__ void rms_row_to_bf16(const float* xrow, const float* g, bf16* orow, int lane) {
    const f32x4* xr = (const f32x4*)xrow + lane; const f32x4* gr = (const f32x4*)g + lane;
    f32x4 v[4]; float s = 0.f;
#pragma unroll
    for (int j = 0; j < 4; ++j) { v[j] = xr[64 * j]; s += (v[j].x * v[j].x + v[j].y * v[j].y) + (v[j].z * v[j].z + v[j].w * v[j].w); }
    const float rstd = 1.f / sqrtf(wave_sum(s) * (1.f / DM) + RMS_EPS);
    unsigned long long* o8 = (unsigned long long*)orow + lane;
#pragma unroll
    for (int j = 0; j < 4; ++j) { const f32x4 gg = gr[64 * j];
        o8[64 * j] = (unsigned long long)pk2(v[j].x * rstd * gg.x, v[j].y * rstd * gg.y) | ((unsigned long long)pk2(v[j].z * rstd * gg.z, v[j].w * rstd * gg.w) << 32); }
}

__device__ __forceinline__ float siluf_(float x) { return x * __builtin_amdgcn_rcpf(1.0f + __builtin_amdgcn_exp2f(-x * LOG2E)); }

typedef short bf16x8v __attribute__((ext_vector_type(8)));
typedef float f32x16 __attribute__((ext_vector_type(16)));
typedef short s16x4 __attribute__((ext_vector_type(4)));
constexpr int HD = 64;
constexpr int ATT_VSLOT = 0, ATT_RPB = 65536, ATT_LSE = ATT_RPB + NHB * 16 * 64 * 4, ATT_ITEM = ATT_LSE + 6144;
constexpr int NA_UNITS = SLAB_SEQ * 6 * 4;
constexpr int NB_ITEMS = SLAB_SEQ * NHB * 8;
__device__ __forceinline__ s16x4 vtr(LAS const char* p) { return __builtin_bit_cast(s16x4, __builtin_amdgcn_ds_read_tr16_b64_v4i16((LAS s16x4*)p)); }
__device__ __forceinline__ unsigned cvtpk(float lo, float hi) { unsigned r; asm volatile("v_cvt_pk_bf16_f32 %0, %1, %2" : "=v"(r) : "v"(lo), "v"(hi)); return r; }
__device__ __forceinline__ int clampi(int v, int lo, int hi) { return v < lo ? lo : (v > hi ? hi : v); }

__device__ __forceinline__ f32x16 qk_tile(const bf16x8v (&kf)[4], const bf16x8v (&qf)[4]) {
    f32x16 sT;
#pragma unroll
    for (int e = 0; e < 16; ++e) sT[e] = 0.f;
#pragma unroll
    for (int s4 = 0; s4 < 4; ++s4) sT = __builtin_amdgcn_mfma_f32_32x32x16_bf16(kf[s4], qf[s4], sT, 0, 0, 0);
    return sT;
}
template <bool CM>
__device__ __forceinline__ void softmax_pv(f32x16& sT, f32x16 (&oT)[2], float& m, float& l, LAS const char* vtrb, bool live, const float (&colm)[16]) {
    float tm = fmaxf(fmaxf(sT[0], sT[1]), fmaxf(sT[2], sT[3]));
#pragma unroll
    for (int e = 4; e < 16; e += 4) tm = fmaxf(tm, fmaxf(fmaxf(sT[e], sT[e + 1]), fmaxf(sT[e + 2], sT[e + 3])));
    { const auto rr = __builtin_amdgcn_permlane32_swap(__float_as_uint(tm), __float_as_uint(tm), false, false); tm = fmaxf(__uint_as_float(rr[0]), __uint_as_float(rr[1])); }
    tm = live ? tm : -1e30f;
    const float mn = fmaxf(m, tm), cr = __builtin_amdgcn_exp2f(m - mn); m = mn;
    const float mref = live ? mn : 1e30f;
    float ps = 0.f;
#pragma unroll
    for (int e = 0; e < 16; ++e) { float p = __builtin_amdgcn_exp2f(sT[e] - mref); if (CM) p *= colm[e]; sT[e] = p; ps += p; }
    l = l * cr + ps;
#pragma unroll
    for (int e = 0; e < 16; ++e) { oT[0][e] *= cr; oT[1][e] *= cr; }
    bf16x8v pf[2];
#pragma unroll
    for (int s2 = 0; s2 < 2; ++s2) { v4u w; w.x = cvtpk(sT[8 * s2 + 0], sT[8 * s2 + 1]); w.y = cvtpk(sT[8 * s2 + 2], sT[8 * s2 + 3]); w.z = cvtpk(sT[8 * s2 + 4], sT[8 * s2 + 5]); w.w = cvtpk(sT[8 * s2 + 6], sT[8 * s2 + 7]); pf[s2] = __builtin_bit_cast(bf16x8v, w); }
#pragma unroll
    for (int dt = 0; dt < 2; ++dt)
#pragma unroll
        for (int s2 = 0; s2 < 2; ++s2) { const s16x4 lo = vtr(vtrb + dt * 2048 + s2 * 1024), hi = vtr(vtrb + dt * 2048 + s2 * 1024 + 512);
            const bf16x8v vf = (bf16x8v){lo[0], lo[1], lo[2], lo[3], hi[0], hi[1], hi[2], hi[3]};
            oT[dt] = __builtin_amdgcn_mfma_f32_32x32x16_bf16(vf, pf[s2], oT[dt], 0, 0, 0); }
}
#define ATT_VWRITE(slot, vc) do { int lw_ = lane; asm volatile("" : "+v"(lw_)); _Pragma("unroll") for (int i_ = 0; i_ < 4; ++i_) { const int key_ = (lw_ >> 3) + 8 * i_, cc_ = lw_ & 7; \
        *(LAS v4u*)((slot) + (cc_ >> 2) * 2048 + key_ * 64 + (cc_ & 3) * 16) = vc[i_]; } } while (0)

__device__ __forceinline__ void attn_a_wave_unit(const bf16* P, bf16* G, LAS float* lseT, LAS char* vslots, int sb, int j, int c, int wu, int lane) {
    asm volatile("" : "+v"(lane));
    const int g = wu >> 4, u = wu & 15, dsh = 2 * g, d = 1 << dsh, Lq = SEQ >> dsh;
    const int r = u & (d - 1), n = u >> dsh, m0 = (512 >> dsh) * c + 32 * n, hA = g * 6 + j;
    const float slope_d = __builtin_amdgcn_exp2f(-8.0f * (float)(g + 3 * j + 1) / 18.0f) * LOG2E * (float)d;
    const int r32 = lane & 31, hi = lane >> 5;
    const size_t seqrow = (size_t)sb * SEQ;
    const int tq = (m0 + r32) * d + r;
    const bf16* qp = P + ((size_t)(H_QA + hA) * MS + seqrow + tq) * 64 + 8 * hi;
    bf16x8v qf[4];
#pragma unroll
    for (int s4 = 0; s4 < 4; ++s4) qf[s4] = *(const bf16x8v*)(qp + 16 * s4);
    const char* Pb = (const char*)P;
    const unsigned kbase0 = (unsigned)((((size_t)(H_KA + hA) * MS + seqrow) * 64) * 2), vbase = (unsigned)((((size_t)(H_VA + hA) * MS + seqrow) * 64) * 2);
    f32x16 oT[2];
#pragma unroll
    for (int e = 0; e < 16; ++e) { oT[0][e] = 0.f; oT[1][e] = 0.f; }
    float m = -1e30f, l = 0.f;
    bf16x8v kfA[4], kfB[4], kfC[4]; v4u vcA[4], vcB[4], vcC[4];
#define A_LOAD(kt, KF, VC) do { int ln_ = lane; asm volatile("" : "+v"(ln_)); const int r32_ = ln_ & 31, hi_ = ln_ >> 5; \
        const int mk_ = clampi(m0 - 64 + 32 * (kt) + r32_, 0, Lq - 1); const unsigned ko_ = kbase0 + (unsigned)(16 * hi_) + (unsigned)(mk_ * d + r) * (unsigned)(HD * 2); \
        _Pragma("unroll") for (int s4 = 0; s4 < 4; ++s4) KF[s4] = *(const bf16x8v*)(Pb + ko_ + 32 * s4); \
        _Pragma("unroll") for (int i_ = 0; i_ < 4; ++i_) { const int key_ = (ln_ >> 3) + 8 * i_, cc_ = ln_ & 7; const int mv_ = clampi(m0 - 64 + 32 * (kt) + key_, 0, Lq - 1); \
            VC[i_] = *(const v4u*)(Pb + vbase + (unsigned)(mv_ * d + r) * (unsigned)(HD * 2) + cc_ * 16); } } while (0)
    LAS const char* vtr0 = vslots + ((lane >> 4) & 1) * 32 + (lane & 3) * 8 + (4 * hi + ((lane & 15) >> 2)) * 64;
#define A_STEP(kt, KF, VC) do { { LAS char* slot_ = vslots + ((kt) & 1) * 4096; ATT_VWRITE(slot_, VC); f32x16 sT = qk_tile(KF, qf); \
        if ((kt) + 3 < 5) A_LOAD((kt) + 3, KF, VC); \
        int lm_ = lane; asm volatile("" : "+v"(lm_)); const int r32m_ = lm_ & 31, him_ = lm_ >> 5; \
        const float obf_ = (float)(32 * (kt) - 64 - r32m_ + 4 * him_); \
        _Pragma("unroll") for (int e = 0; e < 16; ++e) { const float of_ = obf_ + (float)((e & 3) + 8 * (e >> 2)); sT[e] = sT[e] - slope_d * __builtin_fabsf(of_); } \
        if ((kt) == 0) { _Pragma("unroll") for (int e = 0; e < 16; ++e) { const int ko = (e & 3) + 8 * (e >> 2); sT[e] = (ko + 4 * him_ >= r32m_) ? sT[e] : -1e30f; } } \
        if ((kt) == 4) { _Pragma("unroll") for (int e = 0; e < 16; ++e) { const int ko = (e & 3) + 8 * (e >> 2); sT[e] = (ko + 4 * him_ <= r32m_) ? sT[e] : -1e30f; } } \
        const int mt_ = m0 - 64 + 32 * (kt); const bool live_ = (mt_ >= 0) & (mt_ < Lq);         \
        softmax_pv<false>(sT, oT, m, l, vtr0 + ((kt) & 1) * 4096, live_, nocm); } } while (0)
    const float nocm[16] = {};
    A_LOAD(0, kfA, vcA); A_LOAD(1, kfB, vcB); A_LOAD(2, kfC, vcC);
    A_STEP(0, kfA, vcA); A_STEP(1, kfB, vcB); A_STEP(2, kfC, vcC); A_STEP(3, kfA, vcA); A_STEP(4, kfB, vcB);
#undef A_LOAD
#undef A_STEP
    const float lt = l + __shfl_xor(l, 32), inv = 1.0f / lt;
    bf16* op = G + (seqrow + tq) * GW + hA * 64 + 4 * hi;
#pragma unroll
    for (int dt = 0; dt < 2; ++dt)
#pragma unroll
        for (int g4 = 0; g4 < 4; ++g4) { unsigned long long w = (unsigned long long)cvtpk(oT[dt][4 * g4] * inv, oT[dt][4 * g4 + 1] * inv) | ((unsigned long long)cvtpk(oT[dt][4 * g4 + 2] * inv, oT[dt][4 * g4 + 3] * inv) << 32);
            *(unsigned long long*)(op + 32 * dt + 8 * g4) = w; }
    if (hi == 0) lseT[(tq - 512 * c) * 3 + g] = m + __builtin_amdgcn_logf(lt);
}
__device__ __forceinline__ void attn_b_wave_unit(const bf16* P, bf16* G, LAS const float* rpbL, LAS char* vslots, int sb, int h, int rp, int cb, int lane) {
    asm volatile("" : "+v"(lane));
    const int r32 = lane & 31, hi = lane >> 5;
    const int r0 = 2 * rp, qr = r0 + (r32 >> 4), qc = 16 * cb + (r32 & 15);
    const int rs_q = clampi(qr - 4, 0, 24), cs_q = clampi(qc - 8, 0, 48);
    const int rsA = clampi(r0 - 4, 0, 24), rsB = clampi(r0 - 3, 0, 24), nk = rsB - rsA + 8, s0 = clampi(16 * cb - 8, 0, 32);
    const size_t seqrow = (size_t)sb * SEQ;
    const int tq = qr * 64 + qc;
    const bf16* qp = P + ((size_t)(H_QB + h) * MS + seqrow + tq) * 64 + 8 * hi;
    bf16x8v qf[4];
#pragma unroll
    for (int s4 = 0; s4 < 4; ++s4) qf[s4] = *(const bf16x8v*)(qp + 16 * s4);
    const char* Pb = (const char*)P;
    const unsigned kbase0 = (unsigned)((((size_t)(H_KB + h) * MS + seqrow + s0) * 64) * 2), vbase = (unsigned)((((size_t)(H_VB + h) * MS + seqrow + s0) * 64) * 2);
    f32x16 oT[2];
#pragma unroll
    for (int e = 0; e < 16; ++e) { oT[0][e] = 0.f; oT[1][e] = 0.f; }
    float m = -1e30f, l = 0.f;
    bf16x8v kfA[4], kfB[4], kfC[4]; v4u vcA[4], vcB[4], vcC[4];
#define B_LOAD(kt, KF, VC) do { int ln_ = lane; asm volatile("" : "+v"(ln_)); const int r32_ = ln_ & 31, hi_ = ln_ >> 5; \
        const int krl_ = (rsA + (kt)) > 31 ? 31 : (rsA + (kt)); const unsigned ko_ = kbase0 + (unsigned)(16 * hi_) + (unsigned)(krl_ * 64 + r32_) * (unsigned)(HD * 2); \
        _Pragma("unroll") for (int s4 = 0; s4 < 4; ++s4) KF[s4] = *(const bf16x8v*)(Pb + ko_ + 32 * s4); \
        _Pragma("unroll") for (int i_ = 0; i_ < 4; ++i_) { const int key_ = (ln_ >> 3) + 8 * i_, cc_ = ln_ & 7; \
            VC[i_] = *(const v4u*)(Pb + vbase + (unsigned)(krl_ * 64 + key_) * (unsigned)(HD * 2) + cc_ * 16); } } while (0)
    LAS const char* vtr0 = vslots + ((lane >> 4) & 1) * 32 + (lane & 3) * 8 + (4 * hi + ((lane & 15) >> 2)) * 64;
#define B_STEP(kt, KF, VC) do { { LAS char* slot_ = vslots + ((kt) & 1) * 4096; ATT_VWRITE(slot_, VC); f32x16 sT = qk_tile(KF, qf); \
        if ((kt) + 3 < 9) B_LOAD((kt) + 3, KF, VC); \
        int lm_ = lane; asm volatile("" : "+v"(lm_)); const int r32m_ = lm_ & 31, him_ = lm_ >> 5; \
        const int qr_ = r0 + (r32m_ >> 4), qc_ = 16 * cb + (r32m_ & 15), rsq_ = clampi(qr_ - 4, 0, 24); \
        const int kr = rsA + (kt); const bool rowv = (kr >= rsq_) & (kr < rsq_ + 8); \
        LAS const float* bb_ = rpbL + (h * 16 + (kr - qr_ + 7)) * 64 + (s0 + 4 * him_ - qc_ + 31); \
        _Pragma("unroll") for (int e = 0; e < 16; ++e) sT[e] += bb_[(e & 3) + 8 * (e >> 2)]; \
        softmax_pv<true>(sT, oT, m, l, vtr0 + ((kt) & 1) * 4096, rowv, colm); } } while (0)
    float colm[16];
#pragma unroll
    for (int e = 0; e < 16; ++e) { const int kc = s0 + 4 * hi + (e & 3) + 8 * (e >> 2); colm[e] = ((kc >= cs_q) & (kc < cs_q + 16)) ? 1.0f : 0.0f; }
    B_LOAD(0, kfA, vcA); B_LOAD(1, kfB, vcB); B_LOAD(2, kfC, vcC);
    B_STEP(0, kfA, vcA); B_STEP(1, kfB, vcB); B_STEP(2, kfC, vcC); B_STEP(3, kfA, vcA); B_STEP(4, kfB, vcB); B_STEP(5, kfC, vcC);
    B_STEP(6, kfA, vcA); B_STEP(7, kfB, vcB); B_STEP(8, kfC, vcC);
#undef B_LOAD
#undef B_STEP
    const float lt = l + __shfl_xor(l, 32), inv = 1.0f / lt;
    const bf16* zp = P + ((size_t)(H_ZB + h) * MS + seqrow + tq) * 64 + 4 * hi;
    bf16* op = G + (seqrow + tq) * GW + WA + h * 64 + 4 * hi;
#pragma unroll
    for (int dt = 0; dt < 2; ++dt)
#pragma unroll
        for (int g4 = 0; g4 < 4; ++g4) { const unsigned long long z = *(const unsigned long long*)(zp + 32 * dt + 8 * g4); const unsigned zl = (unsigned)z, zh = (unsigned)(z >> 32);
            unsigned long long w = (unsigned long long)cvtpk(oT[dt][4 * g4] * inv * siluf_(bflo(zl)), oT[dt][4 * g4 + 1] * inv * siluf_(bfhi(zl))) |
                                   ((unsigned long long)cvtpk(oT[dt][4 * g4 + 2] * inv * siluf_(bflo(zh)), oT[dt][4 * g4 + 3] * inv * siluf_(bfhi(zh))) << 32);
            *(unsigned long long*)(op + 32 * dt + 8 * g4) = w; }
}
__device__ __forceinline__ void mixer_phase(LAS unsigned char* L, const bf16* P, bf16* G, const float* rpb, unsigned* ctr, int tid) {
    const int lane = tid & 63, wave = __builtin_amdgcn_readfirstlane(tid >> 6);
    LAS float* rpbL = (LAS float*)(L + ATT_RPB); LAS float* lseT = (LAS float*)(L + ATT_LSE); volatile LAS int* itemw = (volatile LAS int*)(L + ATT_ITEM);
    LAS char* vslots = (LAS char*)(L + ATT_VSLOT + wave * 8192);
    for (int i = tid; i < NHB * 16 * 64; i += NTHR) { const int hh = i >> 10, dr = (i >> 6) & 15, x = i & 63; rpbL[i] = (dr < 15 && x >= 16 && x < 47) ? rpb[(hh * 15 + dr) * 31 + x - 16] * LOG2E : 0.f; }
    for (;;) {
        __syncthreads();
        if (tid == 0) *itemw = (int)atomicAdd(ctr, 1u);
        __syncthreads();
        const int item = __builtin_amdgcn_readfirstlane(*itemw);
        if (item >= NA_UNITS + NB_ITEMS) break;
        if (item < NA_UNITS) {
            const int sb = item / 24, j = (item / 4) % 6, c = item & 3;
            for (int i = 0; i < 6; ++i) attn_a_wave_unit(P, G, lseT, vslots, sb, j, c, wave + 8 * i, lane);
            __syncthreads();
            const size_t row0 = (size_t)sb * SEQ + 512 * c;
#pragma unroll 1
            for (int e0 = tid; e0 < 512 * 24; e0 += NTHR * 8) {
                v4u ov[8], zv[8];
#pragma unroll
                for (int b8 = 0; b8 < 8; ++b8) { const int e = e0 + b8 * NTHR, tok = e / 24, rem = e - tok * 24, g = rem >> 3, c8 = rem & 7, hA = g * 6 + j;
                    ov[b8] = *(const v4u*)(G + (row0 + tok) * GW + hA * 64 + c8 * 8); zv[b8] = *(const v4u*)(P + ((size_t)(H_ZA + hA) * MS + row0 + tok) * 64 + c8 * 8); }
#pragma unroll
                for (int b8 = 0; b8 < 8; ++b8) { const int e = e0 + b8 * NTHR, tok = e / 24, rem = e - tok * 24, g = rem >> 3, c8 = rem & 7, hA = g * 6 + j;
                    const float l0 = lseT[tok * 3], l1 = lseT[tok * 3 + 1], l2 = lseT[tok * 3 + 2], lm = fmaxf(l0, fmaxf(l1, l2));
                    const float e0_ = __builtin_amdgcn_exp2f(l0 - lm), e1_ = __builtin_amdgcn_exp2f(l1 - lm), e2_ = __builtin_amdgcn_exp2f(l2 - lm);
                    const float alpha = (g == 0 ? e0_ : (g == 1 ? e1_ : e2_)) / (e0_ + e1_ + e2_);
                    const v4u o = ov[b8], z = zv[b8];
                    v4u w; w.x = pk2(bflo(o.x) * alpha * siluf_(bflo(z.x)), bfhi(o.x) * alpha * siluf_(bfhi(z.x))); w.y = pk2(bflo(o.y) * alpha * siluf_(bflo(z.y)), bfhi(o.y) * alpha * siluf_(bfhi(z.y)));
                    w.z = pk2(bflo(o.z) * alpha * siluf_(bflo(z.z)), bfhi(o.z) * alpha * siluf_(bfhi(z.z))); w.w = pk2(bflo(o.w) * alpha * siluf_(bflo(z.w)), bfhi(o.w) * alpha * siluf_(bfhi(z.w)));
                    *(v4u*)(G + (row0 + tok) * GW + hA * 64 + c8 * 8) = w; }
            }
        } else {
            const int it = item - NA_UNITS, sb = it / (NHB * 8), h = (it >> 3) % NHB, pr = it & 7;
            attn_b_wave_unit(P, G, rpbL, vslots, sb, h, 2 * pr + (wave >> 2), wave & 3, lane);
        }
    }
}


#define XB_TMO      128
#define XB_XCNT(j)  (256  + 64 * (j))
#define XB_XSUB(j)  (1280 + 64 * (j))
#define XB_XGEN(j)  (2304 + 64 * (j))
#define XB_TOP      3328
#define XB_TOPGEN   3392
#define XCD_BAR_WORDS 3456
#define XB_SPIN_CAP (1u << 18)
__device__ __forceinline__ unsigned xb_ld(unsigned* p)              { return __hip_atomic_load(p, __ATOMIC_RELAXED, __HIP_MEMORY_SCOPE_AGENT); }
__device__ __forceinline__ unsigned xb_add(unsigned* p, unsigned v) { return __hip_atomic_fetch_add(p, v, __ATOMIC_RELAXED, __HIP_MEMORY_SCOPE_AGENT); }
__device__ __forceinline__ unsigned xb_xcc_id() { return (unsigned)__builtin_amdgcn_s_getreg((3 << 11) | 20) & 0xFu; }
#define XB_SPIN(cond, bar) do { unsigned _sp = 0; while (cond) { __builtin_amdgcn_s_sleep(1); \
    if ((++_sp & 255u) == 0u) { if (xb_ld(&(bar)[XB_TMO])) break; if (_sp > XB_SPIN_CAP) { atomicAdd(&(bar)[XB_TMO], 1u); break; } } } } while (0)
struct XcdBarrier { unsigned* bar; unsigned x; volatile LAS unsigned* st; };
__device__ __forceinline__ XcdBarrier xcd_barrier_post(unsigned* bar, volatile LAS unsigned* st, bool leader) {
    XcdBarrier b; b.bar = bar; b.x = xb_xcc_id(); b.st = st;
    if (leader) (void)xb_add(&bar[XB_XCNT(b.x)], 1u);
    return b;
}
__device__ __forceinline__ void xcd_barrier_complete(unsigned* bar, unsigned x, unsigned& nloc, unsigned& nx) {
    const unsigned G = gridDim.x * gridDim.y * gridDim.z;
    unsigned sum, cnt, mine, sp = 0u;
    for (;;) {
        sum = 0u; cnt = 0u; mine = 0u;
#pragma unroll 1
        for (unsigned j = 0; j < 16; ++j) { const unsigned c = xb_ld(&bar[XB_XCNT(j)]); sum += c; cnt += (c > 0u) ? 1u : 0u; mine = (j == x) ? c : mine; }
        if (sum == G) break;
        __builtin_amdgcn_s_sleep(1);
        if ((++sp & 255u) == 0u) { if (xb_ld(&bar[XB_TMO])) break; if (sp > XB_SPIN_CAP) { atomicAdd(&bar[XB_TMO], 1u); break; } }
    }
    nloc = mine > 0u ? mine : 1u; nx = cnt > 0u ? cnt : 1u;
}
__device__ __forceinline__ void xcd_barrier(const XcdBarrier& b, bool leader) {
    asm volatile("s_waitcnt vmcnt(0)" ::: "memory");
    __syncthreads();
    if (leader) {
        unsigned* bar = b.bar; asm volatile("" : "+s"(bar));
        __builtin_amdgcn_s_waitcnt(0);
        unsigned nloc = b.st[0], nx = b.st[1];
        if (nloc == 0u) { xcd_barrier_complete(bar, b.x, nloc, nx); b.st[0] = nloc; b.st[1] = nx; }
        const unsigned old = xb_add(&bar[XB_XSUB(b.x)], 1u);
        const unsigned gen = old / nloc;
        if (old + 1u == (gen + 1u) * nloc) {
            __builtin_amdgcn_fence(__ATOMIC_RELEASE, "agent");
            asm volatile("s_waitcnt vmcnt(0)" ::: "memory");
            const unsigned og = xb_add(&bar[XB_TOP], 1u);
            const unsigned tg = og / nx;
            if (og + 1u == (tg + 1u) * nx) xb_add(&bar[XB_TOPGEN], 1u);
            else XB_SPIN(xb_ld(&bar[XB_TOPGEN]) == tg, bar);
            __builtin_amdgcn_fence(__ATOMIC_ACQUIRE, "agent");
            xb_add(&bar[XB_XGEN(b.x)], 1u);
            asm volatile("s_waitcnt vmcnt(0)" ::: "memory");
        } else {
            XB_SPIN(xb_ld(&bar[XB_XGEN(b.x)]) == gen, bar);
            __builtin_amdgcn_fence(__ATOMIC_ACQUIRE, "agent");
            asm volatile("s_waitcnt vmcnt(0)" ::: "memory");
        }
    }
    __syncthreads();
}

struct Args { const float* in[10]; float* out; unsigned char* ws; };
__global__ void __launch_bounds__(NTHR, 2) fwd_megakernel(Args args) {
    extern __shared__ __attribute__((aligned(16))) unsigned char lds[];
    cg::grid_group grid = cg::this_grid();
    LAS unsigned char* L = (LAS unsigned char*)lds;
    volatile LAS unsigned* MISC = (volatile LAS unsigned*)(L + LDS_BYTES - 64);
    const int G = gridDim.x, bx = blockIdx.x;
    const int wave_s = __builtin_amdgcn_readfirstlane(threadIdx.x >> 6);
    XcdBarrier xbar;
    { const int t0 = threadIdx.x; if (t0 < 16) MISC[t0] = 0u;
      __syncthreads();
      xbar = xcd_barrier_post((unsigned*)(args.ws + WS_CTL) + 4096, MISC + 8, t0 == 0); }
#define GRID_BAR() do { int l_; asm volatile("v_mbcnt_lo_u32_b32 %0, -1, 0\n\tv_mbcnt_hi_u32_b32 %0, -1, %0" : "=v"(l_)); xcd_barrier(xbar, wave_s == 0 && l_ == 0); } while (0)
    const int NGW = G * NWAVES; const long nthr = (long)G * NTHR;
#define PHASE_IDS() int lane; asm volatile("v_mbcnt_lo_u32_b32 %0, -1, 0\n\tv_mbcnt_hi_u32_b32 %0, -1, %0" : "=v"(lane)); const int wave = wave_s, tid = wave * 64 + lane, gw = bx * NWAVES + wave; const long gtid = (long)bx * NTHR + tid; (void)gw; (void)gtid
    unsigned char* ws = args.ws;
    const float *xp = args.in[0], *xs = args.in[1], *norm_pre = args.in[2], *w_in = args.in[3], *b_gate = args.in[4], *rpb = args.in[5], *w_pa = args.in[6], *w_pb = args.in[7], *w_out = args.in[8], *norm_post = args.in[9];
    bf16* WIN = (bf16*)(ws + WS_WIN); bf16* WAB = (bf16*)(ws + WS_WAB); bf16* WOUT = (bf16*)(ws + WS_WOUT);
    float* SS = (float*)(ws + WS_SS); float* LSE = (float*)(ws + WS_LSE); unsigned* CTR = (unsigned*)(ws + WS_CTL);
    bf16* XN = (bf16*)(ws + WS_XN); bf16* PROJ = (bf16*)(ws + WS_PROJ); bf16* GB_ = (bf16*)(ws + WS_G); bf16* MG = (bf16*)(ws + WS_MG);

    {
        PHASE_IDS();
        LAS float* scr = (LAS float*)(L + wave * 16384);
        constexpr int I_IN = (DM / 64) * (INC / 32), I_A = (WA / 64) * (DM / 32), I_B = (WB / 64) * (DM / 32), I_O = (DM / 64) * (DM / 32);
        for (int it = gw; it < I_IN + I_A + I_B + I_O; it += NGW) {
            int r = it;
            if (r < I_IN) { p0_transpose_item(w_in, DM, INC, WIN, DM, 0, true, scr, r, lane); continue; } r -= I_IN;
            if (r < I_A) { p0_transpose_item(w_pa, WA, DM, WAB, GW, 0, false, scr, r, lane); continue; } r -= I_A;
            if (r < I_B) { p0_transpose_item(w_pb, WB, DM, WAB, GW, WA, false, scr, r, lane); continue; } r -= I_B;
            p0_transpose_item(w_out, DM, DM, WOUT, DM, 0, false, scr, r, lane);
        }
        for (long i = gtid; i < MTOT; i += nthr) SS[i] = 0.f;
        if (gtid < 64) CTR[gtid] = 0u;
    }
    for (int s = 0; s < NSLAB; ++s) {
        const float* xsl = (s == 0) ? xp : xs + (size_t)(s - 1) * MS * DM;
        float* osl = args.out + (size_t)s * MS * DM;
        float* sssl = SS + (size_t)s * MS;
        const bf16 *XNp = XN, *WINp = WIN, *WABp = WAB, *WOUTp = WOUT, *MGp = MG; bf16* Gp = GB_;
        asm volatile("" : "+s"(XNp), "+s"(WINp), "+s"(WABp), "+s"(WOUTp), "+s"(MGp), "+s"(Gp));
        { PHASE_IDS(); for (int m = gw; m < MS; m += NGW) rms_row_to_bf16(xsl + (size_t)m * DM, norm_pre, XN + (size_t)m * DM, lane); }
        if (s == 0) grid.sync(); else GRID_BAR();
        { pg8::Gemm g{XNp, WINp, MS, INC, DM}; pg8::StaticOrder S; S.init(MS, INC, G, bx); pg8::EpiProj E{PROJ, b_gate};
          PHASE_IDS(); pg8::gemm_phase<pg8::EpiProj, pg8::StaticOrder>(L, g, S, E, tid); }
        GRID_BAR();
        { PHASE_IDS(); mixer_phase(L, PROJ, GB_, rpb, CTR + s, tid); }
        GRID_BAR();
        { pg8::Gemm g{Gp, WABp, MS, DM, GW}; pg8::StaticOrder S; S.init(MS, DM, G, bx); pg8::EpiGate E{PROJ, MG};
          PHASE_IDS(); pg8::gemm_phase<pg8::EpiGate, pg8::StaticOrder>(L, g, S, E, tid); }
        GRID_BAR();
        { pg8::Gemm g{MGp, WOUTp, MS, DM, DM}; pg8::StaticOrder S; S.init(MS, DM, G, bx); pg8::EpiOut E{osl, sssl};
          PHASE_IDS(); pg8::gemm_phase<pg8::EpiOut, pg8::StaticOrder>(L, g, S, E, tid); }
        GRID_BAR();
        { PHASE_IDS();
        for (int m = gw; m < MS; m += NGW) {
            const float rstd = 1.f / sqrtf(sssl[m] * (1.f / DM) + RMS_EPS);
            const f32x4* xr = (const f32x4*)(xsl + (size_t)m * DM) + lane; f32x4* tr = (f32x4*)(osl + (size_t)m * DM) + lane; const f32x4* gr = (const f32x4*)norm_post + lane;
#pragma unroll
            for (int j = 0; j < 4; ++j) { const f32x4 t = tr[64 * j], x = xr[64 * j], gg = gr[64 * j]; tr[64 * j] = x + t * rstd * gg; }
        } }
    }
}

extern "C" void kernel_launch(void* const* d_in, const int* in_sizes, int n_in, void* d_out, int out_size, void* d_ws, size_t ws_size, hipStream_t stream) {
    static int grid = 0;
    if (grid == 0) {
        if (n_in != 10 || out_size != MTOT * DM || ws_size < WS_END) { fprintf(stderr, "kernel_launch: bad shapes: n_in %d out %d ws %zu (need %zu)\n", n_in, out_size, ws_size, (size_t)WS_END); grid = -1; return; }
        int dev = 0, cus = 0, per_cu = 0;
        hipGetDevice(&dev); hipDeviceGetAttribute(&cus, hipDeviceAttributeMultiprocessorCount, dev);
        if (hipFuncSetAttribute((const void*)fwd_megakernel, hipFuncAttributeMaxDynamicSharedMemorySize, LDS_BYTES) != hipSuccess) { fprintf(stderr, "kernel_launch: hipFuncSetAttribute failed\n"); grid = -1; return; }
        hipOccupancyMaxActiveBlocksPerMultiprocessor(&per_cu, (const void*)fwd_megakernel, NTHR, LDS_BYTES);
        if (per_cu < 1) { fprintf(stderr, "kernel_launch: occupancy query says %d blocks per CU\n", per_cu); per_cu = 1; }
        (void)hipGetLastError();
        grid = cus;
    }
    if (grid < 0) return;
    if (hipMemsetAsync((char*)d_ws + WS_CTL, 0, 65536, stream) != hipSuccess) { fprintf(stderr, "kernel_launch: memset failed\n"); return; }
    Args a{};
    for (int i = 0; i < 10; ++i) a.in[i] = (const float*)d_in[i];
    a.out = (float*)d_out; a.ws = (unsigned char*)d_ws;
    void* kargs[] = {&a};
    hipError_t e = hipLaunchCooperativeKernel((const void*)fwd_megakernel, dim3(grid), dim3(NTHR), kargs, LDS_BYTES, stream);
    if (e != hipSuccess) fprintf(stderr, "cooperative launch failed: %s (grid %d)\n", hipGetErrorString(e), grid);
}
```
